# Optimizing an MI355X kernel written in HIP

```python
import jax
import jax.numpy as jnp
from jax import lax
import numpy as np

D_MODEL = 2048
BATCH = 4
SEQ = 4096
DEPTH = 2

GRID_W = 64
CTX_LEN = 256
D_MIX = D_MODEL
D_A = D_MIX // 2
NA_HEAD_DIM = 64
NA_HEADS = D_A // NA_HEAD_DIM
NA_KH_MAX = 8
NA_KW = 16
D_B = D_MIX // 4
GLA_HEADS = 4
GLA_DV = D_B // GLA_HEADS
GLA_DK = GLA_DV // 2
DK_B = GLA_HEADS * GLA_DK
GATE_RANK = 16
GATE_TAU = 16.0
GLA_CHUNK = 64
D_C = D_MIX - D_A - D_B
CONV_K = 31

ROPE_BASE = 10000.0
LN_EPS = 1e-5
RMS_EPS = 1e-6
DEEPNORM_ALPHA = (2 * DEPTH) ** 0.25
DEEPNORM_BETA = (8 * DEPTH) ** -0.25
SPLIT_SIZES = (D_A, D_A, D_A, D_A, DK_B, DK_B, D_B, D_B, 2 * GATE_RANK, D_C, D_C, D_C)
N_IN = 4 * D_A + 2 * DK_B + 2 * D_B + 2 * GATE_RANK + 3 * D_C

kernel_name = 'hybrid_na_gla_conformer_dit'


def _layer_norm(x):
    xf = x.astype(jnp.float32)
    mu = jnp.mean(xf, axis=-1, keepdims=True)
    var = jnp.mean(jnp.square(xf - mu), axis=-1, keepdims=True)
    return ((xf - mu) * lax.rsqrt(var + LN_EPS)).astype(x.dtype)


def _rms_norm(x, g):
    xf = x.astype(jnp.float32)
    y = xf * lax.rsqrt(jnp.mean(jnp.square(xf), axis=-1, keepdims=True) + RMS_EPS)
    return y.astype(x.dtype) * g


def _split_proj(p):
    idx, acc = [], 0
    for s in SPLIT_SIZES[:-1]:
        acc += s
        idx.append(acc)
    return jnp.split(p, idx, axis=-1)


def _rope_1d(x, pos):
    d = x.shape[-1]
    inv = ROPE_BASE ** (-jnp.arange(0, d, 2, dtype=jnp.float32) / d)
    ang = pos[:, None] * inv[None, :]
    cos = jnp.cos(ang)[None, :, None, :].astype(x.dtype)
    sin = jnp.sin(ang)[None, :, None, :].astype(x.dtype)
    x1, x2 = jnp.split(x, 2, axis=-1)
    return jnp.concatenate([x1 * cos - x2 * sin, x1 * sin + x2 * cos], axis=-1)


def _axial_rope(x, rows, cols):
    xr, xc = jnp.split(x, 2, axis=-1)
    return jnp.concatenate([_rope_1d(xr, rows), _rope_1d(xc, cols)], axis=-1)


def _neighbourhood_attention(q, k, v, kc, vc, rpb):
    B, L, H, Dh = q.shape
    rows = L // GRID_W
    kh = min(NA_KH_MAX, rows)
    qg = q.reshape(B, rows, GRID_W, H, Dh)
    kg = k.reshape(B, rows, GRID_W, H, Dh)
    vg = v.reshape(B, rows, GRID_W, H, Dh)
    col = jnp.arange(GRID_W)
    col_start = jnp.clip(col - NA_KW // 2, 0, GRID_W - NA_KW)
    col_idx = col_start[:, None] + jnp.arange(NA_KW)[None, :]
    dcol = col_idx - col[:, None] + (NA_KW - 1)
    scale = Dh ** -0.5
    n_loc = kh * NA_KW

    def row_block(r):
        rs = jnp.clip(r - kh // 2, 0, rows - kh)
        q_r = lax.dynamic_index_in_dim(qg, r, axis=1, keepdims=False)
        k_rows = lax.dynamic_slice_in_dim(kg, rs, kh, axis=1)
        v_rows = lax.dynamic_slice_in_dim(vg, rs, kh, axis=1)
        k_win = k_rows[:, :, col_idx]
        v_win = v_rows[:, :, col_idx]
        drow = rs + jnp.arange(kh) - r + (NA_KH_MAX - 1)
        bias = rpb[:, drow[:, None, None], dcol[None, :, :]]
        s_loc = jnp.einsum('bqhd,biqjhd->bhqij', q_r, k_win) * scale + jnp.transpose(bias, (0, 2, 1, 3))[None]
        s_loc = s_loc.reshape(B, H, GRID_W, n_loc)
        s_ctx = jnp.einsum('bqhd,bkhd->bhqk', q_r, kc) * scale
        p = jax.nn.softmax(jnp.concatenate([s_loc, s_ctx], axis=-1).astype(jnp.float32), axis=-1).astype(v.dtype)
        p_loc = p[..., :n_loc].reshape(B, H, GRID_W, kh, NA_KW)
        p_ctx = p[..., n_loc:]
        return (jnp.einsum('bhqij,biqjhd->bqhd', p_loc, v_win)
                + jnp.einsum('bhqk,bkhd->bqhd', p_ctx, vc))

    out = lax.map(row_block, jnp.arange(rows))
    return jnp.moveaxis(out, 0, 1).reshape(B, L, H * Dh)


def _context_attention(q, k, v):
    B, Lc, H, Dh = q.shape
    s = jnp.einsum('bqhd,bkhd->bhqk', q, k) * Dh ** -0.5
    p = jax.nn.softmax(s.astype(jnp.float32), axis=-1).astype(v.dtype)
    return jnp.einsum('bhqk,bkhd->bqhd', p, v).reshape(B, Lc, H * Dh)


def _to_chunks(t):
    B, L, H, D = t.shape
    return t.reshape(B, L // GLA_CHUNK, GLA_CHUNK, H, D).transpose(0, 1, 3, 2, 4)


def _from_chunks(t):
    B, N, H, C, D = t.shape
    return t.transpose(0, 1, 3, 2, 4).reshape(B, N * C, H, D)


def _gla_chunk_terms(kc, vc, gc):
    b = jnp.cumsum(gc, axis=3)
    b_last = b[:, :, :, -1:, :]
    kv = jnp.einsum('bnhck,bnhcv->bnhkv', kc * jnp.exp(b_last - b), vc)
    decay = jnp.exp(b_last[:, :, :, 0, :])
    return b, kv, decay


def _gla_states(kv, decay, s0):
    def step(s, inp):
        kv_n, d_n = inp
        return d_n[..., None] * s + kv_n, s
    s_fin, starts = lax.scan(step, s0, (jnp.moveaxis(kv, 1, 0), jnp.moveaxis(decay, 1, 0)))
    return jnp.moveaxis(starts, 0, 1), s_fin


def _gla_forward(q, k, v, g, s0):
    dt = v.dtype
    qc = _to_chunks(q.astype(jnp.float32))
    kc = _to_chunks(k.astype(jnp.float32))
    vc = _to_chunks(v.astype(jnp.float32))
    gc = _to_chunks(g)
    b, kv, decay = _gla_chunk_terms(kc, vc, gc)
    starts, s_fin = _gla_states(kv, decay, s0)
    q_t = qc * jnp.exp(b)
    k_t = kc * jnp.exp(-b)
    mask = jnp.tril(jnp.ones((GLA_CHUNK, GLA_CHUNK), dtype=bool))
    att = jnp.where(mask, jnp.einsum('bnhik,bnhjk->bnhij', q_t, k_t), 0.0)
    o = jnp.einsum('bnhck,bnhkv->bnhcv', q_t, starts) + jnp.einsum('bnhij,bnhjv->bnhiv', att, vc)
    return _from_chunks(o).astype(dt), s_fin


def _gla_final_state(k, v, g, s0):
    kc = _to_chunks(k.astype(jnp.float32))
    vc = _to_chunks(v.astype(jnp.float32))
    _, kv, decay = _gla_chunk_terms(kc, vc, _to_chunks(g))
    _, s_fin = _gla_states(kv, decay, s0)
    return s_fin


def _gla_log_decay(glr, w2, b):
    B, L, _ = glr.shape
    lr = glr.astype(jnp.float32).reshape(B, L, 2, GATE_RANK)
    logits = jnp.einsum('bldr,drk->bldk', lr, w2.astype(jnp.float32)) + b.astype(jnp.float32)
    g = (jax.nn.log_sigmoid(logits) / GATE_TAU).reshape(B, L, 2, GLA_HEADS, GLA_DK)
    return g[:, :, 0], g[:, :, 1]


def _conformer_conv(a, gt, w, bconv, ln_g, ln_b):
    u = a * jax.nn.sigmoid(gt)
    u = lax.conv_general_dilated(u, w[:, None, :].astype(u.dtype), window_strides=(1,),
                                 padding=[(CONV_K // 2, CONV_K // 2)],
                                 dimension_numbers=('NWC', 'WIO', 'NWC'),
                                 feature_group_count=u.shape[-1]) + bconv
    return jax.nn.silu(_layer_norm(u) * ln_g + ln_b)


def _layer(x, cx, c, c_ctx, w_ada, b_ada, w_in, rpb, gla_w2, gla_b, gla_norm,
           conv_w, conv_b, conv_ln_g, conv_ln_b, w_out, post_ln_g, post_ln_b, last):
    B, L, _ = x.shape
    Lc = cx.shape[1]
    shift, scale, gate = jnp.split(jax.nn.silu(c) @ w_ada + b_ada, 3, axis=-1)
    shift_c, scale_c, gate_c = jnp.split(jax.nn.silu(c_ctx) @ w_ada + b_ada, 3, axis=-1)
    h = _layer_norm(x) * (1 + scale[:, None]) + shift[:, None]
    hc = _layer_norm(cx) * (1 + scale_c) + shift_c
    qa, ka, va, za, qb, kb, vb, zb, glr, ca, cg, zc = _split_proj(h @ w_in)
    qa_c, ka_c, va_c, za_c, qb_c, kb_c, vb_c, zb_c, glr_c, ca_c, cg_c, zc_c = _split_proj(hc @ w_in)

    def heads_a(t):
        return t.reshape(t.shape[0], t.shape[1], NA_HEADS, NA_HEAD_DIM)

    def heads_k(t):
        return t.reshape(t.shape[0], t.shape[1], GLA_HEADS, GLA_DK)

    def heads_v(t):
        return t.reshape(t.shape[0], t.shape[1], GLA_HEADS, GLA_DV)

    kca, vca = heads_a(ka_c), heads_a(va_c)
    out_a = _neighbourhood_attention(heads_a(qa), heads_a(ka), heads_a(va), kca, vca, rpb) * jax.nn.silu(za)

    pos = jnp.arange(L)
    rows_pos = (pos // GRID_W).astype(jnp.float32)
    cols_pos = (pos % GRID_W).astype(jnp.float32)
    q_scale = GLA_DK ** -0.5
    qbh = _axial_rope(heads_k(qb), rows_pos, cols_pos) * q_scale
    kbh = _axial_rope(heads_k(kb), rows_pos, cols_pos)
    vbh = heads_v(vb)
    g_f, g_b = _gla_log_decay(glr, gla_w2, gla_b)
    kbc, vbc = heads_k(kb_c), heads_v(vb_c)
    gc_f, gc_b = _gla_log_decay(glr_c, gla_w2, gla_b)
    s0 = jnp.zeros((B, GLA_HEADS, GLA_DK, GLA_DV), jnp.float32)
    flip = lambda t: jnp.flip(t, axis=1)
    if last:
        s_f = _gla_final_state(kbc, vbc, gc_f, s0)
        s_b = _gla_final_state(flip(kbc), flip(vbc), flip(gc_b), s0)
    else:
        qbc = heads_k(qb_c) * q_scale
        oc_f, s_f = _gla_forward(qbc, kbc, vbc, gc_f, s0)
        oc_b, s_b = _gla_forward(flip(qbc), flip(kbc), flip(vbc), flip(gc_b), s0)
        oc = oc_f + flip(oc_b)
    o_f, _ = _gla_forward(qbh, kbh, vbh, g_f, s_f)
    o_b, _ = _gla_forward(flip(qbh), flip(kbh), flip(vbh), flip(g_b), s_b)
    out_b = _rms_norm(o_f + flip(o_b), gla_norm).reshape(B, L, D_B) * jax.nn.silu(zb)

    out_c = _conformer_conv(ca, cg, conv_w, conv_b, conv_ln_g, conv_ln_b) * jax.nn.silu(zc)

    y = jnp.concatenate([out_a, out_b, out_c], axis=-1) @ w_out
    x_new = _layer_norm(DEEPNORM_ALPHA * x + gate[:, None] * y) * post_ln_g + post_ln_b
    if last:
        return x_new, None

    out_a_c = _context_attention(heads_a(qa_c), kca, vca) * jax.nn.silu(za_c)
    out_b_c = _rms_norm(oc, gla_norm).reshape(B, Lc, D_B) * jax.nn.silu(zb_c)
    out_c_c = _conformer_conv(ca_c, cg_c, conv_w, conv_b, conv_ln_g, conv_ln_b) * jax.nn.silu(zc_c)
    yc = jnp.concatenate([out_a_c, out_b_c, out_c_c], axis=-1) @ w_out
    cx_new = _layer_norm(DEEPNORM_ALPHA * cx + gate_c * yc) * post_ln_g + post_ln_b
    return x_new, cx_new


def setup_inputs(seed: int = 0) -> dict:
    key = jax.random.key(seed)
    ks = jax.random.split(key, 20)
    nrm = jax.random.normal
    D = D_MODEL
    return {
        'x': nrm(ks[0], (BATCH, SEQ, D), jnp.float32),
        'c': nrm(ks[1], (BATCH, D), jnp.float32),
        'ctx': nrm(ks[2], (BATCH, CTX_LEN, D), jnp.float32),
        'c_ctx': nrm(ks[3], (D,), jnp.float32),
        'w_ada': nrm(ks[4], (DEPTH, D, 3 * D), jnp.float32) * (0.5 * D ** -0.5),
        'b_ada': nrm(ks[5], (DEPTH, 3 * D), jnp.float32) * 0.02,
        'w_in': nrm(ks[6], (DEPTH, D, N_IN), jnp.float32) * D ** -0.5,
        'rpb': nrm(ks[7], (DEPTH, NA_HEADS, 2 * NA_KH_MAX - 1, 2 * NA_KW - 1), jnp.float32) * 0.02,
        'gla_w2': nrm(ks[8], (DEPTH, 2, GATE_RANK, DK_B), jnp.float32) * GATE_RANK ** -0.5,
        'gla_b': nrm(ks[9], (DEPTH, 2, DK_B), jnp.float32) * 0.1,
        'gla_norm': 1.0 + 0.01 * nrm(ks[10], (DEPTH, GLA_DV), jnp.float32),
        'conv_w': nrm(ks[11], (DEPTH, CONV_K, D_C), jnp.float32) * CONV_K ** -0.5,
        'conv_b': nrm(ks[12], (DEPTH, D_C), jnp.float32) * 0.01,
        'conv_ln_g': 1.0 + 0.01 * nrm(ks[13], (DEPTH, D_C), jnp.float32),
        'conv_ln_b': nrm(ks[14], (DEPTH, D_C), jnp.float32) * 0.01,
        'w_out': nrm(ks[15], (DEPTH, D_MIX, D), jnp.float32) * (D_MIX ** -0.5 * DEEPNORM_BETA),
        'post_ln_g': 1.0 + 0.01 * nrm(ks[16], (DEPTH, D), jnp.float32),
        'post_ln_b': nrm(ks[17], (DEPTH, D), jnp.float32) * 0.01,
    }


def reference(x, c, ctx, c_ctx, w_ada, b_ada, w_in, rpb, gla_w2, gla_b, gla_norm,
              conv_w, conv_b, conv_ln_g, conv_ln_b, w_out, post_ln_g, post_ln_b):
    cx = ctx
    for l in range(DEPTH):
        x, cx = _layer(x, cx, c, c_ctx, w_ada[l], b_ada[l], w_in[l], rpb[l], gla_w2[l], gla_b[l],
                       gla_norm[l], conv_w[l], conv_b[l], conv_ln_g[l], conv_ln_b[l], w_out[l],
                       post_ln_g[l], post_ln_b[l], last=(l == DEPTH - 1))
    return x
```

```cpp
#include <hip/hip_runtime.h>
#include <hip/hip_cooperative_groups.h>
#include <cstdio>
namespace cg = cooperative_groups;

#define LAS __attribute__((address_space(3)))
typedef unsigned short bf16_t;
typedef short bf16x8 __attribute__((ext_vector_type(8)));
typedef float f32x4 __attribute__((ext_vector_type(4)));
typedef unsigned u32x4 __attribute__((ext_vector_type(4)));
typedef unsigned u32x2 __attribute__((ext_vector_type(2)));

constexpr int D = 2048, SEQ = 4096, LC = 256, NLAT = 16384, MROWS = 17408;
constexpr int NIN = 7200, NINP = 7424, PS = 6208;
constexpr int PC_QA = 0, PC_KA = 1024, PC_ZA = 2048, PC_QB = 3072, PC_KB = 3328, PC_VB = 3584, PC_ZB = 4096, PC_GLR = 4608, PC_CA = 4640, PC_CG = 5152, PC_ZC = 5664;
constexpr int NCHUNK = 68;
constexpr float ALPHA = 1.4142135623730951f;
constexpr size_t WS_WINT = 0;
constexpr size_t WS_WOUTT = WS_WINT + (size_t)2 * NINP * D * 2;
constexpr size_t WS_MOD = WS_WOUTT + (size_t)2 * D * D * 2;
constexpr size_t WS_ROPE = WS_MOD + (size_t)2 * 5 * 6144 * 4;
constexpr size_t WS_ACT = WS_ROPE + 8192;
constexpr size_t WS_P = WS_ACT + (size_t)MROWS * D * 2;
constexpr size_t WS_VT = WS_P + (size_t)MROWS * PS * 2;
constexpr size_t WS_VTC = WS_VT + (size_t)4 * 16 * 64 * 4096 * 2;
constexpr size_t WS_KVT = WS_VTC + (size_t)4 * 16 * 64 * 256 * 2;
constexpr size_t WS_DEC = WS_KVT + (size_t)2 * 16 * NCHUNK * 8192 * 4;
constexpr size_t WS_XC = WS_DEC + (size_t)2 * 16 * NCHUNK * 64 * 4;
constexpr size_t WS_KVS = WS_XC + (size_t)1024 * D * 4;
constexpr size_t WS_Y = WS_KVT;
constexpr size_t WS_KT = WS_KVS;
constexpr size_t WS_END = WS_KVS + (size_t)2 * 16 * NCHUNK * 8192 * 2;
constexpr size_t WS_BAR = (WS_END + 255) & ~(size_t)255;
constexpr int XCD_BAR_WORDS = 3456;
constexpr size_t WS_TOTAL = WS_BAR + (size_t)XCD_BAR_WORDS * 4;
constexpr int LDS_BYTES = 147456;

struct Params {
    const float *x, *c, *ctx, *c_ctx, *w_ada, *b_ada, *w_in, *rpb, *gla_w2, *gla_b, *gla_norm, *conv_w, *conv_b, *conv_ln_g, *conv_ln_b, *w_out, *post_ln_g, *post_ln_b;
    float* out; unsigned char* ws; int ph_lo, ph_hi;
};

typedef float f32x2_t __attribute__((ext_vector_type(2)));
typedef __bf16 bf16x2_t __attribute__((ext_vector_type(2)));
__device__ __forceinline__ unsigned cvt_pk_bf16(float lo, float hi) { const f32x2_t v = {lo, hi}; return __builtin_bit_cast(unsigned, __builtin_convertvector(v, bf16x2_t)); }
__device__ __forceinline__ bf16_t f2bf(float f) { return (bf16_t)(cvt_pk_bf16(f, 0.f) & 0xffffu); }
__device__ __forceinline__ float bf2f(bf16_t v) { return __uint_as_float(((unsigned)v) << 16); }
__device__ __forceinline__ float bflo(unsigned w) { return __uint_as_float(w << 16); }
__device__ __forceinline__ float bfhi(unsigned w) { return __uint_as_float(w & 0xffff0000u); }
__device__ __forceinline__ void unpack8(u32x4 w, float (&f)[8]) {
    f[0] = bflo(w[0]); f[1] = bfhi(w[0]); f[2] = bflo(w[1]); f[3] = bfhi(w[1]); f[4] = bflo(w[2]); f[5] = bfhi(w[2]); f[6] = bflo(w[3]); f[7] = bfhi(w[3]);
}
__device__ __forceinline__ u32x4 pack8(const float (&f)[8]) { u32x4 w; w[0] = cvt_pk_bf16(f[0], f[1]); w[1] = cvt_pk_bf16(f[2], f[3]); w[2] = cvt_pk_bf16(f[4], f[5]); w[3] = cvt_pk_bf16(f[6], f[7]); return w; }
__device__ __forceinline__ float silu_f(float x) { return x * __builtin_amdgcn_rcpf(1.f + __expf(-x)); }
__device__ __forceinline__ float sigm_f(float x) { return __builtin_amdgcn_rcpf(1.f + __expf(-x)); }
__device__ __forceinline__ float wsum(float v) {
#pragma unroll
    for (int o = 32; o >= 1; o >>= 1) v += __shfl_xor(v, o, 64);
    return v;
}
__device__ __forceinline__ int tid_fresh() { int t = threadIdx.x; asm volatile("" : "+v"(t)); return t; }
__device__ __forceinline__ f32x4 mfma16(bf16x8 a, bf16x8 b, f32x4 c) { return __builtin_amdgcn_mfma_f32_16x16x32_bf16(a, b, c, 0, 0, 0); }

namespace pg8 {
constexpr int BM = 256, BK = 64, HALF = 128, HTB = HALF * BK * 2, STAGE_BYTES = 8 * HTB, NXCD = 8, WGM = 8;
__host__ __device__ __forceinline__ int lds_byte(int r, int c) { const int st = (r >> 4) * 2 + (c >> 5), rr = r & 15, cc = c & 31, ob = rr * 64 + cc * 2; return st * 1024 + (ob ^ (((ob >> 9) & 1) << 5)); }
__host__ __device__ __forceinline__ void stage_rc(int b, int& R, int& C) { const int st = b / 1024, sb = b % 1024, swz = sb ^ (((sb >> 9) & 1) << 5); R = (st >> 1) * 16 + swz / 64; C = (st & 1) * 32 + (swz % 64) / 2; }
__host__ __device__ __forceinline__ int perm32(int rho) { const int n = rho >> 4, i = rho & 15; return 8 * (i >> 2) + 4 * n + (i & 3); }
struct Unit { int pm, pn; };
struct Gemm { const bf16_t* A; const bf16_t* Bt; int M, N, K; };
struct StaticOrder {
    int nM, nN, nwg, G, c;
    __host__ __device__ void init(int M, int N, int G_, int c_) { nM = M / BM; nN = N / BM; nwg = nM * nN; G = G_; c = c_; }
    __host__ __device__ bool next(int i, Unit& u) const {
        const long L = (long)i * G + c; if (L >= nwg) return false;
        int wgid = (int)L; { const int q = nwg / NXCD, r = nwg % NXCD, xcd = wgid % NXCD, off = wgid / NXCD; wgid = (xcd < r ? xcd * (q + 1) : r * (q + 1) + (xcd - r) * q) + off; }
        const int nig = WGM * nN, gid = wgid / nig, fm = gid * WGM, gsz = (nM - fm) < WGM ? (nM - fm) : WGM;
        u.pm = fm + ((wgid % nig) % gsz); u.pn = (wgid % nig) / gsz; return true;
    }
};

template <class Epi>
__device__ __forceinline__ void gemm_phase(LAS unsigned char* lds, const Gemm g, const StaticOrder& S, const Epi& E) {
    const int tid = tid_fresh(), wid = __builtin_amdgcn_readfirstlane(tid >> 6), lane = tid & 63, wr = wid >> 2, wc = wid & 3, fr = lane & 15, fq = lane >> 4;
    const int K = g.K, nt = K / BK;
    unsigned voffA[2], voffB[2];
#pragma unroll
    for (int i = 0; i < 2; ++i) { int R, C; stage_rc(tid * 16 + i * 8192, R, C); const int Rb = Epi::PERM ? ((R & ~31) + perm32(R & 31)) : R;
        voffA[i] = (unsigned)(R * K + C) * 2u; voffB[i] = (unsigned)(Rb * K + C) * 2u; }
    const size_t kstep = (size_t)(BK * 2);
    const size_t hstep = (size_t)HALF * K * 2;
    const size_t tstep = 2 * hstep;
    const unsigned ldsw = (unsigned)wid * 1024u;
    const int aoff = lds_byte(wr * 64 + fr, fq * 8), boff = lds_byte(wc * 32 + fr, fq * 8);
#define PG8_SA(b, h) (((b) * 2 + (h)) * HTB)
#define PG8_SB(b, h) ((4 + (b) * 2 + (h)) * HTB)
#define PG8_STAGE(bufoff, gbase, voff) do { _Pragma("unroll") for (int _i = 0; _i < 2; ++_i) \
        __builtin_amdgcn_global_load_lds((const unsigned*)((const char*)(gbase) + (voff)[_i]), (LAS unsigned*)(lds + (bufoff) + ldsw + _i * 8192), 16, 0, 0); } while (0)
#define PG8_LDA(dst, b, h) do { _Pragma("unroll") for (int m = 0; m < 4; ++m) _Pragma("unroll") for (int k = 0; k < 2; ++k) dst[m][k] = *(const LAS bf16x8*)(lds + PG8_SA(b, h) + aoff + m * 2048 + k * 1024); } while (0)
#define PG8_LDB(dst, b, h) do { _Pragma("unroll") for (int n = 0; n < 2; ++n) _Pragma("unroll") for (int k = 0; k < 2; ++k) dst[n][k] = *(const LAS bf16x8*)(lds + PG8_SB(b, h) + boff + n * 2048 + k * 1024); } while (0)
#define PG8_MMA(ai, bj, At, Bt) do { __builtin_amdgcn_s_setprio(1); _Pragma("unroll") for (int m = 0; m < 4; ++m) _Pragma("unroll") for (int n = 0; n < 2; ++n) _Pragma("unroll") for (int k = 0; k < 2; ++k) \
        acc[ai][bj][m][n] = __builtin_amdgcn_mfma_f32_16x16x32_bf16(Bt[n][k], At[m][k], acc[ai][bj][m][n], 0, 0, 0); __builtin_amdgcn_s_setprio(0); } while (0)
#define PG8_WAIT_V(n) asm volatile("s_waitcnt vmcnt(" #n ")" ::: "memory")
#define PG8_WAIT_L(n) asm volatile("s_waitcnt lgkmcnt(" #n ")" ::: "memory")
#define PG8_BAR __builtin_amdgcn_s_barrier()
#define PG8_SCHED __builtin_amdgcn_sched_barrier(0)
    Unit cur, nxt; int ui = 0;
    if (!S.next(0, cur)) return;
    f32x4 acc[2][2][4][2];
#pragma unroll
    for (int a = 0; a < 2; ++a)
#pragma unroll
        for (int b = 0; b < 2; ++b)
#pragma unroll
            for (int m = 0; m < 4; ++m)
#pragma unroll
                for (int n = 0; n < 2; ++n) acc[a][b][m][n] = (f32x4){0.f, 0.f, 0.f, 0.f};
    bf16x8 At[4][2], B0[2][2], B1[2][2];
    const char* cA = (const char*)g.A + (size_t)cur.pm * tstep; const char* cB = (const char*)g.Bt + (size_t)cur.pn * tstep;
    PG8_STAGE(PG8_SB(0, 0), cB, voffB); PG8_STAGE(PG8_SA(0, 0), cA, voffA); PG8_STAGE(PG8_SB(0, 1), cB + hstep, voffB); PG8_STAGE(PG8_SA(0, 1), cA + hstep, voffA);
    if (wr == 1) PG8_BAR;
    PG8_WAIT_V(4); PG8_BAR;
    PG8_STAGE(PG8_SB(1, 0), cB + kstep, voffB); PG8_STAGE(PG8_SA(1, 0), cA + kstep, voffA); PG8_STAGE(PG8_SB(1, 1), cB + hstep + kstep, voffB);
    PG8_WAIT_V(6); PG8_BAR;
    for (;;) {
        const bool has_next = S.next(ui + 1, nxt);
        const char* nA = has_next ? (const char*)g.A + (size_t)nxt.pm * tstep : cA; const char* nB = has_next ? (const char*)g.Bt + (size_t)nxt.pn * tstep : cB;
        for (int t = 0; t < nt; t += 2) {
            const bool last = (t == nt - 2);
            const char* a1 = cA + (size_t)(t + 1) * kstep;
            const char* a2 = last ? nA : cA + (size_t)(t + 2) * kstep; const char* b2 = last ? nB : cB + (size_t)(t + 2) * kstep;
            const char* a3 = a2 + kstep; const char* b3 = b2 + kstep;
            PG8_LDB(B0, 0, 0); PG8_SCHED; PG8_LDA(At, 0, 0); PG8_STAGE(PG8_SA(1, 1), a1 + hstep, voffA);
            PG8_WAIT_L(8); PG8_BAR; PG8_WAIT_L(0); PG8_MMA(0, 0, At, B0); PG8_BAR; PG8_SCHED;
            PG8_LDB(B1, 0, 1); PG8_STAGE(PG8_SB(0, 0), b2, voffB);
            PG8_BAR; PG8_WAIT_L(0); PG8_MMA(0, 1, At, B1); PG8_BAR;
            PG8_LDA(At, 0, 1); PG8_STAGE(PG8_SA(0, 0), a2, voffA);
            PG8_BAR; PG8_WAIT_L(0); PG8_MMA(1, 0, At, B0); PG8_BAR; PG8_SCHED;
            PG8_STAGE(PG8_SB(0, 1), b2 + hstep, voffB);
            PG8_WAIT_V(6); PG8_BAR; PG8_MMA(1, 1, At, B1); PG8_BAR;
            PG8_LDB(B0, 1, 0); PG8_SCHED; PG8_LDA(At, 1, 0); PG8_STAGE(PG8_SA(0, 1), a2 + hstep, voffA);
            PG8_WAIT_L(8); PG8_BAR; PG8_WAIT_L(0); PG8_MMA(0, 0, At, B0); PG8_BAR; PG8_SCHED;
            PG8_LDB(B1, 1, 1); PG8_STAGE(PG8_SB(1, 0), b3, voffB);
            PG8_BAR; PG8_WAIT_L(0); PG8_MMA(0, 1, At, B1); PG8_BAR;
            PG8_LDA(At, 1, 1); PG8_STAGE(PG8_SA(1, 0), a3, voffA);
            PG8_BAR; PG8_WAIT_L(0); PG8_MMA(1, 0, At, B0); PG8_BAR; PG8_SCHED;
            PG8_STAGE(PG8_SB(1, 1), b3 + hstep, voffB);
            PG8_WAIT_V(6); PG8_BAR; PG8_MMA(1, 1, At, B1); PG8_BAR;
        }
        E(acc, cur, wr, wc, fr, fq);
        if (!has_next) break;
#pragma unroll
        for (int a = 0; a < 2; ++a)
#pragma unroll
            for (int b = 0; b < 2; ++b)
#pragma unroll
                for (int m = 0; m < 4; ++m)
#pragma unroll
                    for (int n = 0; n < 2; ++n) acc[a][b][m][n] = (f32x4){0.f, 0.f, 0.f, 0.f};
        cur = nxt; cA = nA; cB = nB; ++ui;
    }
    PG8_WAIT_V(0);
    if (wr == 0) PG8_BAR;
    PG8_BAR;
#undef PG8_SA
#undef PG8_SB
#undef PG8_STAGE
#undef PG8_LDA
#undef PG8_LDB
#undef PG8_MMA
#undef PG8_WAIT_V
#undef PG8_WAIT_L
#undef PG8_BAR
#undef PG8_SCHED
}
}

struct EpiIn {
    static constexpr bool PERM = true;
    bf16_t* P; bf16_t* VT; bf16_t* VTC; bf16_t* KT;
    __device__ __forceinline__ void operator()(const f32x4 (&acc)[2][2][4][2], const pg8::Unit& u, int wr, int wc, int fr, int fq) const {
        const int row0 = u.pm * 256 + wr * 64 + fr;
        if (u.pn >= 8 && u.pn < 12) {
            const int c0 = (u.pn - 8) * 256 + wc * 32 + 8 * fq;
            if (u.pm < 64) {
                const int b = u.pm >> 4, t0 = row0 - b * 4096;
#pragma unroll
                for (int ai = 0; ai < 2; ++ai)
#pragma unroll
                    for (int m = 0; m < 4; ++m) { const int t = t0 + ai * 128 + m * 16;
#pragma unroll
                        for (int bj = 0; bj < 2; ++bj)
#pragma unroll
                            for (int n = 0; n < 2; ++n)
#pragma unroll
                                for (int j = 0; j < 4; ++j) { const int c = c0 + bj * 128 + 4 * n + j;
                                    VT[((((size_t)(b * 16 + (c >> 6)) * 512 + (t >> 3)) * 64 + (((c & 3) << 4) | ((c & 63) >> 2))) << 3) + (t & 7)] = f2bf(acc[ai][bj][m][n][j]); } }
            } else {
                const int b = u.pm - 64, t0 = row0 - NLAT - b * 256; bf16_t* base = VTC + (size_t)b * 1024 * 256;
#pragma unroll
                for (int ai = 0; ai < 2; ++ai)
#pragma unroll
                    for (int m = 0; m < 4; ++m) { const int t = t0 + ai * 128 + m * 16;
#pragma unroll
                        for (int bj = 0; bj < 2; ++bj)
#pragma unroll
                            for (int n = 0; n < 2; ++n)
#pragma unroll
                                for (int j = 0; j < 4; ++j) { const int c = c0 + bj * 128 + 4 * n + j; base[(size_t)((c & ~63) | ((c & 3) << 4) | ((c & 63) >> 2)) * 256 + t] = f2bf(acc[ai][bj][m][n][j]); } }
            }
        } else {
            const bool ktile = u.pn >= 4 && u.pn < 8 && u.pm < 64;
            const int cdst0 = u.pn * 256 - (u.pn >= 12 ? 1024 : 0) + wc * 32 + 8 * fq;
            const int ck0 = (u.pn - 4) * 256 + wc * 32 + 8 * fq, bb = u.pm >> 4;
#pragma unroll
            for (int ai = 0; ai < 2; ++ai)
#pragma unroll
                for (int m = 0; m < 4; ++m) { const int row = row0 + ai * 128 + m * 16; bf16_t* rowp = P + (size_t)row * PS + cdst0; const int t = row - bb * 4096;
#pragma unroll
                    for (int bj = 0; bj < 2; ++bj) if (u.pn < 28 || (bj == 0 && wc == 0)) {
                        const f32x4 v0 = acc[ai][bj][m][0], v1 = acc[ai][bj][m][1]; u32x4 w;
                        w[0] = cvt_pk_bf16(v0[0], v0[1]); w[1] = cvt_pk_bf16(v0[2], v0[3]); w[2] = cvt_pk_bf16(v1[0], v1[1]); w[3] = cvt_pk_bf16(v1[2], v1[3]);
                        bf16_t* dst = rowp + bj * 128;
                        if (ktile) { const int ck = ck0 + bj * 128, hh = ck >> 6, dim0 = ck & 63;
                            dst = KT + ((((((size_t)(bb * 16 + hh) * 1024 + (t >> 2)) * 2 + (dim0 >> 5)) * 4 + (t & 3)) << 5) + (dim0 & 31)); }
                        *(u32x4*)dst = w; } }
        }
    }
};
struct EpiOut {
    static constexpr bool PERM = false;
    const float* xlat; const float* xctx; float* olat; float* octx; const float* gate;
    __device__ __forceinline__ void operator()(const f32x4 (&acc)[2][2][4][2], const pg8::Unit& u, int wr, int wc, int fr, int fq) const {
        const int row0 = u.pm * 256 + wr * 64 + fr, col0 = u.pn * 256 + wc * 32 + 4 * fq;
#pragma unroll
        for (int ai = 0; ai < 2; ++ai)
#pragma unroll
            for (int m = 0; m < 4; ++m) { const int row = row0 + ai * 128 + m * 16; const float* xs; float* od; int mr;
                if (row < NLAT) { xs = xlat + (size_t)row * D; od = olat + (size_t)row * D; mr = row >> 12; } else { xs = xctx + (size_t)(row - NLAT) * D; od = octx + (size_t)(row - NLAT) * D; mr = 4; }
#pragma unroll
                for (int bj = 0; bj < 2; ++bj)
#pragma unroll
                    for (int n = 0; n < 2; ++n) { const int c = col0 + bj * 128 + n * 16;
                        const f32x4 xv = *(const f32x4*)(xs + c), gv = *(const f32x4*)(gate + mr * 6144 + c);
                        *(f32x4*)(od + c) = xv * ALPHA + gv * acc[ai][bj][m][n]; } }
    }
};

struct EpiOutY {
    static constexpr bool PERM = true;
    bf16_t* Y;
    __device__ __forceinline__ void operator()(const f32x4 (&acc)[2][2][4][2], const pg8::Unit& u, int wr, int wc, int fr, int fq) const {
        const int row0 = u.pm * 256 + wr * 64 + fr, c0 = u.pn * 256 + wc * 32 + 8 * fq;
#pragma unroll
        for (int ai = 0; ai < 2; ++ai)
#pragma unroll
            for (int m = 0; m < 4; ++m) { bf16_t* rowp = Y + (size_t)(row0 + ai * 128 + m * 16) * D + c0;
#pragma unroll
                for (int bj = 0; bj < 2; ++bj) { const f32x4 v0 = acc[ai][bj][m][0], v1 = acc[ai][bj][m][1]; u32x4 w;
                    w[0] = cvt_pk_bf16(v0[0], v0[1]); w[1] = cvt_pk_bf16(v0[2], v0[3]); w[2] = cvt_pk_bf16(v1[0], v1[1]); w[3] = cvt_pk_bf16(v1[2], v1[3]);
                    *(u32x4*)(rowp + bj * 128) = w; } }
    }
};

__device__ __forceinline__ void transpose_tile(const float* __restrict__ src, int N, bf16_t* __restrict__ dst, int kt, int nt, float* tile) {
    const int tid = tid_fresh(), k0 = kt * 64, n0 = nt * 256, wid = tid >> 6, nc = (tid & 63) * 4;
    f32x4 v[8];
#pragma unroll
    for (int i = 0; i < 8; ++i) { v[i] = (f32x4){0.f, 0.f, 0.f, 0.f}; if (n0 + nc < N) v[i] = *(const f32x4*)(src + (size_t)(k0 + wid + 8 * i) * N + n0 + nc); }
#pragma unroll
    for (int i = 0; i < 8; ++i) { float* tp = tile + (wid + 8 * i) * 257 + nc; tp[0] = v[i][0]; tp[1] = v[i][1]; tp[2] = v[i][2]; tp[3] = v[i][3]; }
    __syncthreads();
    { const int n = tid >> 1, ks = (tid & 1) * 32;
#pragma unroll
      for (int q = 0; q < 4; ++q) { float f[8];
#pragma unroll
          for (int e = 0; e < 8; ++e) f[e] = tile[(ks + q * 8 + e) * 257 + n];
          *(u32x4*)(dst + (size_t)(n0 + n) * D + k0 + ks + q * 8) = pack8(f); } }
    __syncthreads();
}

static __device__ void phase_prep(const Params& p, unsigned char* shm) {
    float* sl = (float*)shm; const int tid = tid_fresh();
    if (blockIdx.x == gridDim.x - 1) {
        float* rope = (float*)(p.ws + WS_ROPE);
        for (int e = tid; e < 1024; e += 512) { const int pos = e >> 4, i = e & 15; const float inv = exp2f(-(float)i * (13.287712379549449f / 16.f)); const float ang = (float)pos * inv;
            rope[e] = cosf(ang); rope[1024 + e] = sinf(ang); }
    }
    constexpr int NG = 192, TIN = 29 * 32, TOUT = 8 * 32, TOTAL = NG + (TIN + TOUT);
    for (int it = blockIdx.x; it < TOTAL; it += gridDim.x) {
        if (it < NG) {
            const int l = it / 96, n0 = (it % 96) * 64;
            for (int e = tid; e < 5 * 2048; e += 512) { const float v = e < 4 * 2048 ? p.c[e] : p.c_ctx[e - 4 * 2048]; sl[e] = silu_f(v); }
            __syncthreads();
            const int cq = tid & 15, ks = tid >> 4; float acc[5][4];
#pragma unroll
            for (int r = 0; r < 5; ++r)
#pragma unroll
                for (int e = 0; e < 4; ++e) acc[r][e] = 0.f;
            const float* W = p.w_ada + (size_t)l * 2048 * 6144 + n0 + 4 * cq;
#pragma unroll 8
            for (int kk = 0; kk < 64; ++kk) { const int k = ks * 64 + kk; const f32x4 w = *(const f32x4*)(W + (size_t)k * 6144);
#pragma unroll
                for (int r = 0; r < 5; ++r) { const float sv = sl[r * 2048 + k]; acc[r][0] += sv * w[0]; acc[r][1] += sv * w[1]; acc[r][2] += sv * w[2]; acc[r][3] += sv * w[3]; } }
            float* red = sl + 10240;
#pragma unroll
            for (int r = 0; r < 5; ++r)
#pragma unroll
                for (int e = 0; e < 4; ++e) red[(ks * 5 + r) * 64 + 4 * cq + e] = acc[r][e];
            __syncthreads();
            if (tid < 320) { const int r = tid >> 6, col = tid & 63; float s = 0.f;
                for (int q = 0; q < 32; ++q) s += red[(q * 5 + r) * 64 + col];
                ((float*)(p.ws + WS_MOD))[(size_t)(l * 5 + r) * 6144 + n0 + col] = s + p.b_ada[(size_t)l * 6144 + n0 + col]; }
            __syncthreads();
        } else {
            int idx = it - NG; const int l = 0;
            if (idx < TIN) transpose_tile(p.w_in + (size_t)l * D * NIN, NIN, (bf16_t*)(p.ws + WS_WINT) + (size_t)l * NINP * D, idx & 31, idx >> 5, sl);
            else { idx -= TIN; transpose_tile(p.w_out + (size_t)l * D * D, D, (bf16_t*)(p.ws + WS_WOUTT) + (size_t)l * D * D, idx & 31, idx >> 5, sl); }
        }
    }
}

static __device__ void convert_layer1_filler(const Params& p, unsigned char* shm) {
    constexpr int TIN = 29 * 32, TOUT = 8 * 32, FIRST = 32;
    float* sl = (float*)shm;
    const int nb = (int)gridDim.x > FIRST ? (int)gridDim.x - FIRST : (int)gridDim.x, b0 = (int)gridDim.x > FIRST ? (int)blockIdx.x - FIRST : (int)blockIdx.x;
    if (b0 < 0) return;
    for (int idx = b0; idx < TIN + TOUT; idx += nb) {
        if (idx < TIN) transpose_tile(p.w_in + (size_t)D * NIN, NIN, (bf16_t*)(p.ws + WS_WINT) + (size_t)NINP * D, idx & 31, idx >> 5, sl);
        else { const int j = idx - TIN; transpose_tile(p.w_out + (size_t)D * D, D, (bf16_t*)(p.ws + WS_WOUTT) + (size_t)D * D, j & 31, j >> 5, sl); }
    }
}

static __device__ void phase_ln(const Params& p, int mode) {
    const int tid_ = tid_fresh(), lane = tid_ & 63, wid = tid_ >> 6;
    const int nrows = mode == 2 ? NLAT : MROWS;
    const float* mod = (const float*)(p.ws + WS_MOD) + (mode == 1 ? 5 * 6144 : 0);
    bf16_t* H = (bf16_t*)(p.ws + WS_ACT);
    float* XC = (float*)(p.ws + WS_XC);
    const int lpost = mode == 1 ? 0 : 1;
    int nw = gridDim.x * 8; asm volatile("" : "+s"(nw));
    for (int rowa = blockIdx.x * 8 + wid; rowa < nrows; rowa += 2 * nw) {
        int rows[2] = {rowa, rowa + nw}; const bool ok1 = rows[1] < nrows; if (!ok1) rows[1] = rowa;
        float* rp[2]; const float* sp[2]; f32x4 v[2][8]; float s[2], mu[2], q[2], rstd[2];
#pragma unroll
        for (int k = 0; k < 2; ++k) { const int row = rows[k];
            if (row < NLAT) { rp[k] = p.out + (size_t)row * D; sp[k] = mode == 2 ? rp[k] : p.x + (size_t)row * D; }
            else { rp[k] = XC + (size_t)(row - NLAT) * D; sp[k] = p.ctx + (size_t)(row - NLAT) * D; } }
#pragma unroll
        for (int k = 0; k < 2; ++k) { s[k] = 0.f;
            const bf16_t* yp = (const bf16_t*)(p.ws + WS_Y) + (size_t)rows[k] * D;
            const float* gp = (const float*)(p.ws + WS_MOD) + (size_t)lpost * 5 * 6144 + 4096 + (rows[k] < NLAT ? rows[k] >> 12 : 4) * 6144;
#pragma unroll
            for (int i = 0; i < 8; ++i) { const int c = (i * 64 + lane) * 4; v[k][i] = *(const f32x4*)(sp[k] + c);
                if (mode != 0) { const u32x2 yw = *(const u32x2*)(yp + c); const f32x4 gv = *(const f32x4*)(gp + c);
                    const f32x4 yv = {bflo(yw[0]), bfhi(yw[0]), bflo(yw[1]), bfhi(yw[1])}; v[k][i] = v[k][i] * ALPHA + gv * yv; }
                s[k] += v[k][i][0] + v[k][i][1] + v[k][i][2] + v[k][i][3]; } }
#pragma unroll
        for (int k = 0; k < 2; ++k) { mu[k] = wsum(s[k]) * (1.f / 2048.f); q[k] = 0.f;
#pragma unroll
            for (int i = 0; i < 8; ++i) { v[k][i] = v[k][i] - mu[k]; q[k] += v[k][i][0] * v[k][i][0] + v[k][i][1] * v[k][i][1] + v[k][i][2] * v[k][i][2] + v[k][i][3] * v[k][i][3]; } }
#pragma unroll
        for (int k = 0; k < 2; ++k) rstd[k] = rsqrtf(wsum(q[k]) * (1.f / 2048.f) + 1e-5f);
        if (mode != 0) {
#pragma unroll
            for (int k = 0; k < 2; ++k) { s[k] = 0.f;
#pragma unroll
                for (int i = 0; i < 8; ++i) { const int c = (i * 64 + lane) * 4; const f32x4 gg = *(const f32x4*)(p.post_ln_g + lpost * D + c), bb = *(const f32x4*)(p.post_ln_b + lpost * D + c);
                    v[k][i] = v[k][i] * rstd[k] * gg + bb; if ((k == 0 || ok1) && rows[k] < NLAT) *(f32x4*)(rp[k] + c) = v[k][i]; s[k] += v[k][i][0] + v[k][i][1] + v[k][i][2] + v[k][i][3]; } }
            if (mode == 2) continue;
#pragma unroll
            for (int k = 0; k < 2; ++k) { mu[k] = wsum(s[k]) * (1.f / 2048.f); q[k] = 0.f;
#pragma unroll
                for (int i = 0; i < 8; ++i) { v[k][i] = v[k][i] - mu[k]; q[k] += v[k][i][0] * v[k][i][0] + v[k][i][1] * v[k][i][1] + v[k][i][2] * v[k][i][2] + v[k][i][3] * v[k][i][3]; } }
#pragma unroll
            for (int k = 0; k < 2; ++k) rstd[k] = rsqrtf(wsum(q[k]) * (1.f / 2048.f) + 1e-5f);
        }
#pragma unroll
        for (int k = 0; k < 2; ++k) { if (k == 1 && !ok1) break; const int row = rows[k]; const int mr = row < NLAT ? row >> 12 : 4; const float* mrow = mod + mr * 6144;
#pragma unroll
            for (int i = 0; i < 8; ++i) { const int c = (i * 64 + lane) * 4; const f32x4 sh = *(const f32x4*)(mrow + c), sc = *(const f32x4*)(mrow + 2048 + c);
                const f32x4 h = v[k][i] * rstd[k] * (sc + 1.f) + sh; u32x2 w; w[0] = cvt_pk_bf16(h[0], h[1]); w[1] = cvt_pk_bf16(h[2], h[3]);
                *(u32x2*)(H + (size_t)row * D + c) = w; } }
    }
}

__device__ __forceinline__ bf16x8 ldx8(const bf16_t* p) { return *(const bf16x8*)p; }
__device__ __forceinline__ bf16x8 ldx8(const LAS bf16_t* p) { return *(const LAS bf16x8*)p; }
template <int NB, bool LOCAL, int KLD, class KP, class VP>
__device__ __forceinline__ void attn_part(const bf16_t* __restrict__ qrow, KP kbase, size_t kblk_stride, VP vtbase, int vt_ld, int vblk_stride,
                                          const float* rpbs, int drow0, int kc0, int qc, int lq, int g, float& m_out, float& l_out, f32x4 (&O)[4]) {
    bf16x8 qf[2];
    qf[0] = *(const bf16x8*)(qrow + 8 * g); qf[1] = *(const bf16x8*)(qrow + 32 + 8 * g);
    f32x4 S[NB][2];
    const int krow = 8 * (lq >> 2) + (lq & 3);
#pragma unroll
    for (int kb = 0; kb < NB; ++kb) {
        auto kp = kbase + (size_t)kb * kblk_stride + (size_t)krow * KLD + 8 * g;
#pragma unroll
        for (int tt = 0; tt < 2; ++tt) { auto kp2 = kp + (size_t)tt * 4 * KLD;
            const bf16x8 k0 = ldx8(kp2), k1 = ldx8(kp2 + 32);
            f32x4 a = {0.f, 0.f, 0.f, 0.f}; a = mfma16(k0, qf[0], a); a = mfma16(k1, qf[1], a); S[kb][tt] = a; }
    }
    float mx = -1e30f;
    const int cs = min(max(qc - 8, 0), 48);
#pragma unroll
    for (int kb = 0; kb < NB; ++kb)
#pragma unroll
        for (int tt = 0; tt < 2; ++tt)
#pragma unroll
            for (int j = 0; j < 4; ++j) { float s = S[kb][tt][j] * 0.125f;
                if (LOCAL) { const int col = kc0 + 8 * g + 4 * tt + j; const int dc = min(max(col - qc + 15, 0), 30); const bool ok = col >= cs && col <= cs + 15;
                    const float bias = rpbs[(drow0 + kb) * 31 + dc]; s = ok ? s + bias : -1e30f; }
                S[kb][tt][j] = s; mx = fmaxf(mx, s); }
    mx = fmaxf(mx, __shfl_xor(mx, 16, 64)); mx = fmaxf(mx, __shfl_xor(mx, 32, 64));
    float l = 0.f;
#pragma unroll
    for (int kb = 0; kb < NB; ++kb)
#pragma unroll
        for (int tt = 0; tt < 2; ++tt)
#pragma unroll
            for (int j = 0; j < 4; ++j) { const float pv = __expf(S[kb][tt][j] - mx); S[kb][tt][j] = pv; l += pv; }
    l += __shfl_xor(l, 16, 64); l += __shfl_xor(l, 32, 64);
#pragma unroll
    for (int kb = 0; kb < NB; ++kb) {
        u32x4 pw; pw[0] = cvt_pk_bf16(S[kb][0][0], S[kb][0][1]); pw[1] = cvt_pk_bf16(S[kb][0][2], S[kb][0][3]); pw[2] = cvt_pk_bf16(S[kb][1][0], S[kb][1][1]); pw[3] = cvt_pk_bf16(S[kb][1][2], S[kb][1][3]);
        const bf16x8 pf = __builtin_bit_cast(bf16x8, pw);
#pragma unroll
        for (int dt = 0; dt < 4; ++dt) { const bf16x8 vf = ldx8(vtbase + (size_t)(16 * dt + lq) * vt_ld + kb * vblk_stride + 8 * g); O[dt] = mfma16(vf, pf, O[dt]); }
    }
    m_out = mx; l_out = l;
}

__device__ __forceinline__ void attn_store_row(const bf16_t* P, bf16_t* CC, size_t orow, int h, int g, const f32x4 (&O)[4], float scale) {
    const int d0 = h * 64 + 16 * g;
#pragma unroll
    for (int hf = 0; hf < 2; ++hf) { float z[8], r[8]; unpack8(*(const u32x4*)(P + orow * PS + PC_ZA + d0 + 8 * hf), z);
#pragma unroll
        for (int k = 0; k < 8; ++k) r[k] = O[k & 3][2 * hf + (k >> 2)] * scale * silu_f(z[k]);
        *(u32x4*)(CC + orow * D + d0 + 8 * hf) = pack8(r); }
}
__device__ __forceinline__ void attn_merge_store(const Params& p, float* mrg, int wid, int lane, int h, size_t orow, float m, float l, f32x4 (&O)[4]) {
    const int cb = wid & 3, lq = lane & 15, g = lane >> 4;
    if (wid >= 4) {
#pragma unroll
        for (int dt = 0; dt < 4; ++dt)
#pragma unroll
            for (int j = 0; j < 4; ++j) mrg[(cb * 18 + dt * 4 + j) * 64 + lane] = O[dt][j];
        mrg[(cb * 18 + 16) * 64 + lane] = m; mrg[(cb * 18 + 17) * 64 + lane] = l;
    }
    __syncthreads();
    if (wid < 4) {
        const float m2 = mrg[(cb * 18 + 16) * 64 + lane], l2 = mrg[(cb * 18 + 17) * 64 + lane];
        const float mm = fmaxf(m, m2), a1 = __expf(m - mm), a2 = __expf(m2 - mm), inv = 1.f / (a1 * l + a2 * l2);
        const bf16_t* P = (const bf16_t*)(p.ws + WS_P); bf16_t* CC = (bf16_t*)(p.ws + WS_ACT);
#pragma unroll
        for (int dt = 0; dt < 4; ++dt)
#pragma unroll
            for (int j = 0; j < 4; ++j) { const float o2 = mrg[(cb * 18 + dt * 4 + j) * 64 + lane]; O[dt][j] = a1 * O[dt][j] + a2 * o2; }
        attn_store_row(P, CC, orow, h, g, O, inv);
    }
    __syncthreads();
}

constexpr int CK_LD = 72, CV_LD = 264;
constexpr float LOG2E = 1.4426950408889634f;
__device__ __forceinline__ void na_pv(const f32x4 s0, const f32x4 s1, const bf16x8 (&vf)[4], float& l, f32x4 (&O)[4]) {
    float p[8];
#pragma unroll
    for (int j = 0; j < 4; ++j) { p[j] = __builtin_amdgcn_exp2f(s0[j]); p[4 + j] = __builtin_amdgcn_exp2f(s1[j]); }
    l += ((p[0] + p[1]) + (p[2] + p[3])) + ((p[4] + p[5]) + (p[6] + p[7]));
    u32x4 pw; pw[0] = cvt_pk_bf16(p[0], p[1]); pw[1] = cvt_pk_bf16(p[2], p[3]); pw[2] = cvt_pk_bf16(p[4], p[5]); pw[3] = cvt_pk_bf16(p[6], p[7]);
    const bf16x8 pf = __builtin_bit_cast(bf16x8, pw);
#pragma unroll
    for (int dt = 0; dt < 4; ++dt) O[dt] = mfma16(vf[dt], pf, O[dt]);
}
static __device__ void na_pair(const Params& p, unsigned char* shm, int l, int pi) {
    const int quarter = pi & 3, bh = pi >> 2, h = bh & 15, b = bh >> 4;
    float* rpbs = (float*)shm + 16;
    bf16_t* cK = (bf16_t*)(shm + 2176);
    bf16_t* cV = cK + 256 * CK_LD;
    const int tid = tid_fresh(), wid = __builtin_amdgcn_readfirstlane(tid >> 6), lane = tid & 63, lq = lane & 15, g = lane >> 4;
    const bf16_t* P = (const bf16_t*)(p.ws + WS_P);
    for (int e = tid - 16; e < 528; e += 512) rpbs[e] = e < 0 ? 0.f : (e < 465 ? p.rpb[(size_t)(l * 16 + h) * 465 + e] * LOG2E : -1e30f);
    for (int e = tid; e < 256 * 8; e += 512) { const int k = e >> 3, sg = e & 7;
        *(u32x4*)(cK + k * CK_LD + sg * 8) = *(const u32x4*)(P + ((size_t)NLAT + b * 256 + k) * PS + PC_KA + h * 64 + sg * 8); }
    { const bf16_t* vt = (const bf16_t*)(p.ws + WS_VTC) + (size_t)((b * 16 + h) * 64) * 256;
      for (int e = tid; e < 64 * 32; e += 512) { const int d = e >> 5, sg = e & 31; *(u32x4*)(cV + d * CV_LD + sg * 8) = *(const u32x4*)(vt + d * 256 + sg * 8); } }
    __syncthreads();
    const LAS bf16_t* cKl = (const LAS bf16_t*)cK; const LAS bf16_t* cVl = (const LAS bf16_t*)cV;
    const int krow = 8 * (lq >> 2) + (lq & 3);
    constexpr float SC2 = 0.125f * LOG2E;
#pragma unroll 1
    for (int wi = wid; wi < 32; wi += 8) {
        const int rA = quarter * 16 + 2 * (wi >> 2), rB = rA + 1, cb = wi & 3;
        const int RA = min(max(rA - 4, 0), 56), RB = min(max(rB - 4, 0), 56), dd = RB - RA;
        const int qc = 16 * cb + lq, cs = min(max(qc - 8, 0), 48);
        const int kc0 = cb == 0 ? 0 : (cb == 1 ? 8 : (cb == 2 ? 24 : 32));
        const size_t rowA = (size_t)b * 4096 + rA * 64 + qc, rowB = rowA + 64;
        bf16x8 qA[2], qB[2];
        { const bf16_t* qp = P + rowA * PS + PC_QA + h * 64 + 8 * g; qA[0] = *(const bf16x8*)qp; qA[1] = *(const bf16x8*)(qp + 32);
          qp += (size_t)64 * PS; qB[0] = *(const bf16x8*)qp; qB[1] = *(const bf16x8*)(qp + 32); }
        float mk[2][4]; const int bbase = kc0 + 8 * g - qc + 15;
#pragma unroll
        for (int tt = 0; tt < 2; ++tt)
#pragma unroll
            for (int j = 0; j < 4; ++j) { const int col = kc0 + 8 * g + 4 * tt + j; mk[tt][j] = (col >= cs && col <= cs + 15) ? 80.f : -1e30f; }
        f32x4 OA[4], OB[4];
#pragma unroll
        for (int dt = 0; dt < 4; ++dt) { OA[dt] = (f32x4){0.f, 0.f, 0.f, 0.f}; OB[dt] = (f32x4){0.f, 0.f, 0.f, 0.f}; }
        float lA = 0.f, lB = 0.f;
        const bf16_t* kb0 = (const bf16_t*)(p.ws + WS_KT) + (size_t)(b * 16 + h) * 262144 + (size_t)(RA * 16 + (kc0 >> 2)) * 256 + (lq >> 2) * 512 + (lq & 3) * 32 + 8 * g;
        const bf16_t* vb0 = (const bf16_t*)(p.ws + WS_VT) + (size_t)(b * 16 + h) * 262144 + (size_t)(RA * 8 + (kc0 >> 3)) * 512 + (g * 64 + lq) * 8;
        {
            const int nrows = 8 + dd;
            bf16x8 kS[2][2][2], vS[2][4];
#define NA_LDL(SL, U) do { const bf16_t* kp_ = kb0 + (size_t)(U) * 4096; \
                kS[SL][0][0] = *(const bf16x8*)kp_; kS[SL][0][1] = *(const bf16x8*)(kp_ + 128); kS[SL][1][0] = *(const bf16x8*)(kp_ + 256); kS[SL][1][1] = *(const bf16x8*)(kp_ + 384); \
                _Pragma("unroll") for (int dt_ = 0; dt_ < 4; ++dt_) vS[SL][dt_] = *(const bf16x8*)(vb0 + (size_t)(U) * 4096 + dt_ * 128); } while (0)
#define NA_ROW(SL, U) do { const int u_ = (U); const bool actA = u_ < 8, actB = u_ >= dd; \
                const int drA = actA ? min(max(RA + u_ - rA + 7, 0), 14) * 31 : 465, drB = actB ? min(max(RA + u_ - rB + 7, 0), 14) * 31 : 465; \
                f32x4 sa[2], sb[2]; \
                _Pragma("unroll") for (int tt = 0; tt < 2; ++tt) { f32x4 a = {0.f, 0.f, 0.f, 0.f}; a = mfma16(kS[SL][tt][0], qA[0], a); a = mfma16(kS[SL][tt][1], qA[1], a); \
                    f32x4 c = {0.f, 0.f, 0.f, 0.f}; c = mfma16(kS[SL][tt][0], qB[0], c); c = mfma16(kS[SL][tt][1], qB[1], c); \
                    _Pragma("unroll") for (int j = 0; j < 4; ++j) { const float ba = rpbs[drA + bbase + 4 * tt + j], bb = rpbs[drB + bbase + 4 * tt + j]; \
                        a[j] = fminf(a[j] * SC2 + ba, mk[tt][j]); c[j] = fminf(c[j] * SC2 + bb, mk[tt][j]); } \
                    sa[tt] = a; sb[tt] = c; } \
                na_pv(sa[0], sa[1], vS[SL], lA, OA); na_pv(sb[0], sb[1], vS[SL], lB, OB); } while (0)
            NA_LDL(0, 0);
#pragma unroll 1
            for (int u = 0; u < 8; u += 2) {
                NA_LDL(1, u + 1);
                NA_ROW(0, u);
                if (u + 2 < nrows) NA_LDL(0, u + 2);
                NA_ROW(1, u + 1);
            }
            if (dd) NA_ROW(0, 8);
#undef NA_ROW
#undef NA_LDL
        }
        {
            bf16x8 kS[2][2][2], vS[2][4];
#define NA_LDC(SL, KB) do { const LAS bf16_t* kp_ = cKl + ((KB) * 32 + krow) * CK_LD + 8 * g; \
                kS[SL][0][0] = *(const LAS bf16x8*)kp_; kS[SL][0][1] = *(const LAS bf16x8*)(kp_ + 32); kS[SL][1][0] = *(const LAS bf16x8*)(kp_ + 4 * CK_LD); kS[SL][1][1] = *(const LAS bf16x8*)(kp_ + 4 * CK_LD + 32); \
                _Pragma("unroll") for (int dt_ = 0; dt_ < 4; ++dt_) vS[SL][dt_] = *(const LAS bf16x8*)(cVl + (16 * dt_ + lq) * CV_LD + (KB) * 32 + 8 * g); } while (0)
#define NA_CTX(SL) do { f32x4 sa[2], sb[2]; \
                _Pragma("unroll") for (int tt = 0; tt < 2; ++tt) { f32x4 a = {0.f, 0.f, 0.f, 0.f}; a = mfma16(kS[SL][tt][0], qA[0], a); a = mfma16(kS[SL][tt][1], qA[1], a); \
                    f32x4 c = {0.f, 0.f, 0.f, 0.f}; c = mfma16(kS[SL][tt][0], qB[0], c); c = mfma16(kS[SL][tt][1], qB[1], c); \
                    _Pragma("unroll") for (int j = 0; j < 4; ++j) { a[j] = fminf(a[j] * SC2, 80.f); c[j] = fminf(c[j] * SC2, 80.f); } \
                    sa[tt] = a; sb[tt] = c; } \
                na_pv(sa[0], sa[1], vS[SL], lA, OA); na_pv(sb[0], sb[1], vS[SL], lB, OB); } while (0)
            NA_LDC(0, 0);
#pragma unroll 1
            for (int kb = 0; kb < 8; kb += 2) {
                NA_LDC(1, kb + 1);
                NA_CTX(0);
                if (kb + 2 < 8) NA_LDC(0, kb + 2);
                NA_CTX(1);
            }
#undef NA_CTX
#undef NA_LDC
        }
        lA += __shfl_xor(lA, 16, 64); lA += __shfl_xor(lA, 32, 64); lB += __shfl_xor(lB, 16, 64); lB += __shfl_xor(lB, 32, 64);
        const float iA = 1.f / lA, iB = 1.f / lB;
        bf16_t* CC = (bf16_t*)(p.ws + WS_ACT);
        attn_store_row(P, CC, rowA, h, g, OA, iA);
        attn_store_row(P, CC, rowB, h, g, OB, iB);
    }
    __syncthreads();
}

static __device__ void ctxattn_item(const Params& p, unsigned char* shm, int item) {
    const int qb = item & 3, h = (item >> 2) & 15, b = item >> 6;
    float* mrg = (float*)shm + 512;
    const int tid = tid_fresh(), wid = tid >> 6, lane = tid & 63, lq = lane & 15, g = lane >> 4, cb = wid & 3;
    const bf16_t* P = (const bf16_t*)(p.ws + WS_P);
    const size_t orow = (size_t)NLAT + b * 256 + qb * 64 + 16 * cb + lq;
    const bf16_t* qrow = P + orow * PS + PC_QA + h * 64;
    f32x4 O[4];
#pragma unroll
    for (int dt = 0; dt < 4; ++dt) O[dt] = (f32x4){0.f, 0.f, 0.f, 0.f};
    float m, lsum;
    const int koff = wid < 4 ? 0 : 128;
    const bf16_t* kbase = P + ((size_t)NLAT + b * 256 + koff) * PS + PC_KA + h * 64;
    const bf16_t* vtbase = (const bf16_t*)(p.ws + WS_VTC) + (size_t)((b * 16 + h) * 64) * 256 + koff;
    attn_part<4, false, PS>(qrow, kbase, (size_t)32 * PS, vtbase, 256, 32, (const float*)shm, 0, 0, 0, lq, g, m, lsum, O);
    attn_merge_store(p, mrg, wid, lane, h, orow, m, lsum, O);
}

static __device__ void conv_item(const Params& p, unsigned char* shm, int l, int item) {
    int b, t0, Lseq; size_t rowbase;
    if (item < 512) { b = item >> 7; t0 = (item & 127) * 32; Lseq = SEQ; rowbase = (size_t)b * 4096; }
    else { const int j = item - 512; b = j >> 3; t0 = (j & 7) * 32; Lseq = LC; rowbase = (size_t)NLAT + b * 256; }
    float* u = (float*)shm;
    const bf16_t* P = (const bf16_t*)(p.ws + WS_P); bf16_t* CC = (bf16_t*)(p.ws + WS_ACT);
    const int tid = tid_fresh(), wid = tid >> 6, lane = tid & 63;
    u32x4 ra[8], rg[8];
#pragma unroll
    for (int it = 0; it < 8; ++it) { const int e = tid + it * 512, tt = e >> 6, c8 = (e & 63) * 8, t = t0 - 15 + tt;
        ra[it] = (u32x4){0u, 0u, 0u, 0u}; rg[it] = (u32x4){0u, 0u, 0u, 0u};
        if (tt < 62 && t >= 0 && t < Lseq) { const bf16_t* rp = P + (rowbase + t) * PS; ra[it] = *(const u32x4*)(rp + PC_CA + c8); rg[it] = *(const u32x4*)(rp + PC_CG + c8); } }
    float w[31];
#pragma unroll
    for (int j = 0; j < 31; ++j) w[j] = p.conv_w[(size_t)(l * 31 + j) * 512 + tid];
    const float bias = p.conv_b[l * 512 + tid];
#pragma unroll
    for (int it = 0; it < 8; ++it) { const int e = tid + it * 512, tt = e >> 6, c8 = (e & 63) * 8;
        if (tt < 62) { float a[8], gt[8], f[8]; unpack8(ra[it], a); unpack8(rg[it], gt);
#pragma unroll
            for (int k = 0; k < 8; ++k) f[k] = a[k] * sigm_f(gt[k]);
            *(f32x4*)(u + tt * 512 + c8) = (f32x4){f[0], f[1], f[2], f[3]}; *(f32x4*)(u + tt * 512 + c8 + 4) = (f32x4){f[4], f[5], f[6], f[7]}; } }
    __syncthreads();
    unsigned zc[4][4];
#pragma unroll
    for (int q = 0; q < 4; ++q)
#pragma unroll
        for (int k = 0; k < 4; ++k) zc[q][k] = *(const unsigned*)(P + (rowbase + t0 + wid * 4 + q) * PS + PC_ZC + 2 * (lane + 64 * k));
    {
        const int ch = tid; float acc[32];
#pragma unroll
        for (int t = 0; t < 32; ++t) acc[t] = bias;
#pragma unroll
        for (int tt = 0; tt < 62; ++tt) { const float val = u[tt * 512 + ch];
#pragma unroll
            for (int t = 0; t < 32; ++t) { const int j = tt - t; if (j >= 0 && j <= 30) acc[t] += w[j] * val; } }
#pragma unroll
        for (int t = 0; t < 32; ++t) u[t * 512 + ch] = acc[t];
    }
    __syncthreads();
    float lg[8], lb[8];
#pragma unroll
    for (int k = 0; k < 4; ++k) { const int ch = 2 * (lane + 64 * k); lg[2 * k] = p.conv_ln_g[l * 512 + ch]; lg[2 * k + 1] = p.conv_ln_g[l * 512 + ch + 1]; lb[2 * k] = p.conv_ln_b[l * 512 + ch]; lb[2 * k + 1] = p.conv_ln_b[l * 512 + ch + 1]; }
#pragma unroll
    for (int q = 0; q < 4; ++q) { const int t = wid * 4 + q; float v[8], s = 0.f;
#pragma unroll
        for (int k = 0; k < 4; ++k) { v[2 * k] = u[t * 512 + 2 * (lane + 64 * k)]; v[2 * k + 1] = u[t * 512 + 2 * (lane + 64 * k) + 1]; s += v[2 * k] + v[2 * k + 1]; }
        const float mu = wsum(s) * (1.f / 512.f); float qq = 0.f;
#pragma unroll
        for (int i = 0; i < 8; ++i) { v[i] -= mu; qq += v[i] * v[i]; }
        const float rstd = rsqrtf(wsum(qq) * (1.f / 512.f) + 1e-5f);
        const size_t row = rowbase + t0 + t;
#pragma unroll
        for (int k = 0; k < 4; ++k) { const float y0 = v[2 * k] * rstd * lg[2 * k] + lb[2 * k], y1 = v[2 * k + 1] * rstd * lg[2 * k + 1] + lb[2 * k + 1];
            *(unsigned*)(CC + row * D + 1536 + 2 * (lane + 64 * k)) = cvt_pk_bf16(silu_f(y0) * silu_f(bflo(zc[q][k])), silu_f(y1) * silu_f(bfhi(zc[q][k]))); } }
    __syncthreads();
}

__device__ __forceinline__ f32x4 mma_lds(const bf16_t* A, int lda, const bf16_t* B, int ldb, int K, int lq, int g, f32x4 acc) {
    for (int k0 = 0; k0 < K; k0 += 32) { const bf16x8 a = *(const bf16x8*)(A + lq * lda + k0 + 8 * g), b = *(const bf16x8*)(B + lq * ldb + k0 + 8 * g); acc = mfma16(a, b, acc); }
    return acc;
}
__device__ __forceinline__ size_t gla_row0(int b, int ci) { return ci < 4 ? (size_t)NLAT + b * 256 + ci * 64 : (size_t)b * 4096 + (ci - 4) * 64; }
__device__ __forceinline__ void gla_load_rope(const Params& p, int tid, float* dst, size_t row0, int colbase, int ci, float scale) {
    const int c = tid >> 3, seg = tid & 7;
    const bf16_t* rp = (const bf16_t*)(p.ws + WS_P) + (row0 + c) * PS + colbase;
    float own[8]; unpack8(*(const u32x4*)(rp + seg * 8), own);
    if (ci >= 4) { float oth[8]; unpack8(*(const u32x4*)(rp + (seg ^ 2) * 8), oth);
        const float* rope = (const float*)(p.ws + WS_ROPE); const int pos = seg < 4 ? ci - 4 : c; const int i0 = (seg & 1) * 8;
        const f32x4 c0 = *(const f32x4*)(rope + pos * 16 + i0), c1 = *(const f32x4*)(rope + pos * 16 + i0 + 4), s0 = *(const f32x4*)(rope + 1024 + pos * 16 + i0), s1 = *(const f32x4*)(rope + 1024 + pos * 16 + i0 + 4);
        const float csv[8] = {c0[0], c0[1], c0[2], c0[3], c1[0], c1[1], c1[2], c1[3]}, snv[8] = {s0[0], s0[1], s0[2], s0[3], s1[0], s1[1], s1[2], s1[3]};
#pragma unroll
        for (int e = 0; e < 8; ++e) { const float cs = csv[e], sn = snv[e];
            own[e] = (seg & 2) ? oth[e] * sn + own[e] * cs : own[e] * cs - oth[e] * sn; } }
    *(f32x4*)(dst + c * 64 + seg * 8) = (f32x4){own[0] * scale, own[1] * scale, own[2] * scale, own[3] * scale};
    *(f32x4*)(dst + c * 64 + seg * 8 + 4) = (f32x4){own[4] * scale, own[5] * scale, own[6] * scale, own[7] * scale};
}
__device__ __forceinline__ void gla_load_vT(const Params& p, int tid, bf16_t* VTs, size_t row0, int h) {
    for (int e = tid; e < 1024; e += 512) { const int c = e >> 4, seg = e & 15;
        const u32x4 w = *(const u32x4*)((const bf16_t*)(p.ws + WS_P) + (row0 + c) * PS + PC_VB + h * 128 + seg * 8);
#pragma unroll
        for (int k = 0; k < 4; ++k) { VTs[(seg * 8 + 2 * k) * 72 + c] = (bf16_t)(w[k] & 0xffffu); VTs[(seg * 8 + 2 * k + 1) * 72 + c] = (bf16_t)(w[k] >> 16); } }
}
__device__ __forceinline__ void gla_stage_gate(const Params& p, int tid, float* w2s, bf16_t* lrs, int l, int h, size_t row0) {
    { const int row = tid >> 4, ch = (tid & 15) * 4; *(f32x4*)(w2s + row * 64 + ch) = *(const f32x4*)(p.gla_w2 + (size_t)(l * 32 + row) * 256 + h * 64 + ch); }
    if (tid < 256) { const int tok = tid >> 2, ch = (tid & 3) * 8; *(u32x4*)(lrs + tok * 32 + ch) = *(const u32x4*)((const bf16_t*)(p.ws + WS_P) + (row0 + tok) * PS + PC_GLR + ch); }
}
__device__ __forceinline__ float gla_g8(const Params& p, int tid, const float* w2s, const bf16_t* lrs, int l, int h, int dir, float (&bl)[8]) {
    const int dk = tid & 63, cgp = tid >> 6;
    float w2r[16];
#pragma unroll
    for (int r = 0; r < 16; ++r) w2r[r] = w2s[(dir * 16 + r) * 64 + dk];
    const float bias = p.gla_b[(l * 2 + dir) * 256 + h * 64 + dk];
    float gv[8];
#pragma unroll
    for (int cc = 0; cc < 8; ++cc) { const bf16_t* lp = lrs + (cgp * 8 + cc) * 32 + dir * 16;
        float t0[8], t1[8]; unpack8(*(const u32x4*)lp, t0); unpack8(*(const u32x4*)(lp + 8), t1);
        float x = bias;
#pragma unroll
        for (int r = 0; r < 8; ++r) x += t0[r] * w2r[r] + t1[r] * w2r[8 + r];
        gv[cc] = (fminf(x, 0.f) - __logf(1.f + __expf(-fabsf(x)))) * (1.f / 16.f); }
    float tot = 0.f;
    if (dir == 0) {
#pragma unroll
        for (int cc = 0; cc < 8; ++cc) { tot += gv[cc]; bl[cc] = tot; }
    } else {
#pragma unroll
        for (int cc = 7; cc >= 0; --cc) { tot += gv[cc]; bl[cc] = tot; }
    }
    return tot;
}

static __device__ void gla_g1_item(const Params& p, unsigned char* shm, int l, int item) {
    const int ci = item % NCHUNK, bh = item / NCHUNK, h = bh & 3, b = bh >> 2;
    float* kf = (float*)shm;
    float* part = kf + 4096;
    bf16_t* VTs = (bf16_t*)(part + 1024);
    bf16_t* KdT = VTs + 128 * 72;
    const int tid = tid_fresh(), wid = tid >> 6, lane = tid & 63, lq = lane & 15, g = lane >> 4, dk = tid & 63, cgp = tid >> 6;
    const size_t row0 = gla_row0(b, ci);
    float* w2s = (float*)(KdT + 2 * 64 * 72);
    bf16_t* lrs = (bf16_t*)(w2s + 2048);
    gla_load_rope(p, tid, kf, row0, PC_KB + h * 64, ci, 1.f);
    gla_load_vT(p, tid, VTs, row0, h);
    gla_stage_gate(p, tid, w2s, lrs, l, h, row0);
    __syncthreads();
    float bl[2][8];
#pragma unroll
    for (int dir = 0; dir < 2; ++dir) part[(dir * 8 + cgp) * 64 + dk] = gla_g8(p, tid, w2s, lrs, l, h, dir, bl[dir]);
    __syncthreads();
#pragma unroll
    for (int dir = 0; dir < 2; ++dir) {
        float off = 0.f, btot = 0.f;
#pragma unroll
        for (int q = 0; q < 8; ++q) { const float pv = part[(dir * 8 + q) * 64 + dk]; btot += pv; if (dir == 0 ? q < cgp : q > cgp) off += pv; }
        const size_t sidx = (size_t)((dir * 4 + b) * 4 + h) * NCHUNK + ci;
        float f[8];
#pragma unroll
        for (int cc = 0; cc < 8; ++cc) { const float bv = bl[dir][cc] + off; f[cc] = kf[(cgp * 8 + cc) * 64 + dk] * __expf(btot - bv); }
        *(u32x4*)(KdT + (dir * 64 + dk) * 72 + cgp * 8) = pack8(f);
        if (cgp == 0) ((float*)(p.ws + WS_DEC))[sidx * 64 + dk] = __expf(btot);
    }
    __syncthreads();
#pragma unroll
    for (int dir = 0; dir < 2; ++dir) {
        const size_t sidx = (size_t)((dir * 4 + b) * 4 + h) * NCHUNK + ci;
        float* KV = (float*)(p.ws + WS_KVT) + sidx * 8192;
#pragma unroll
        for (int nt = 0; nt < 4; ++nt) { f32x4 acc = {0.f, 0.f, 0.f, 0.f}; acc = mma_lds(VTs + (16 * wid) * 72, 72, KdT + (dir * 64 + 16 * nt) * 72, 72, 64, lq, g, acc);
#pragma unroll
            for (int j = 0; j < 4; ++j) KV[(16 * wid + 4 * g + j) * 64 + 16 * nt + lq] = acc[j]; }
    }
    __syncthreads();
}

static __device__ void gla_scan_item(const Params& p, int item) {
    const int slab = item & 15, seq = item >> 4, dir = seq >> 4;
    const int e = slab * 512 + tid_fresh(), dk = e & 63;
    const float* KV = (const float*)(p.ws + WS_KVT) + (size_t)seq * NCHUNK * 8192 + e;
    bf16_t* KVS = (bf16_t*)(p.ws + WS_KVS) + (size_t)seq * NCHUNK * 8192 + e;
    const float* DEC = (const float*)(p.ws + WS_DEC) + (size_t)seq * NCHUNK * 64 + dk;
    float s = 0.f;
#pragma unroll 1
    for (int s0 = 0; s0 < NCHUNK; s0 += 17) { float kv[17], dc[17];
#pragma unroll
        for (int q = 0; q < 17; ++q) { const int st = s0 + q; const int ci = dir == 0 ? st : (st < 4 ? 3 - st : 71 - st); kv[q] = KV[(size_t)ci * 8192]; dc[q] = DEC[ci * 64]; }
#pragma unroll
        for (int q = 0; q < 17; ++q) { const int st = s0 + q; const int ci = dir == 0 ? st : (st < 4 ? 3 - st : 71 - st); KVS[(size_t)ci * 8192] = f2bf(s); s = dc[q] * s + kv[q]; } }
}

__device__ __forceinline__ void gla_cum(const Params& p, int tid, float* part, int l, int h, int dir, size_t row0, float (&bl)[8], float& btot) {
    const int dk = tid & 63, cgp = tid >> 6;
    float w2r[16];
#pragma unroll
    for (int r = 0; r < 16; ++r) w2r[r] = p.gla_w2[(size_t)((l * 2 + dir) * 16 + r) * 256 + h * 64 + dk];
    const float bias = p.gla_b[(l * 2 + dir) * 256 + h * 64 + dk];
    float gv[8];
#pragma unroll
    for (int cc = 0; cc < 8; ++cc) { const bf16_t* lp = (const bf16_t*)(p.ws + WS_P) + (row0 + cgp * 8 + cc) * PS + PC_GLR + dir * 16;
        float lr[16]; { float t8[8]; unpack8(*(const u32x4*)lp, t8);
#pragma unroll
            for (int e = 0; e < 8; ++e) lr[e] = t8[e];
            unpack8(*(const u32x4*)(lp + 8), t8);
#pragma unroll
            for (int e = 0; e < 8; ++e) lr[8 + e] = t8[e]; }
        float x = bias;
#pragma unroll
        for (int r = 0; r < 16; ++r) x += lr[r] * w2r[r];
        gv[cc] = (fminf(x, 0.f) - __logf(1.f + __expf(-fabsf(x)))) * (1.f / 16.f); }
    float tot = 0.f;
    if (dir == 0) {
#pragma unroll
        for (int cc = 0; cc < 8; ++cc) { tot += gv[cc]; bl[cc] = tot; }
    } else {
#pragma unroll
        for (int cc = 7; cc >= 0; --cc) { tot += gv[cc]; bl[cc] = tot; }
    }
    part[cgp * 64 + dk] = tot;
    __syncthreads();
    float off = 0.f; btot = 0.f;
#pragma unroll
    for (int q = 0; q < 8; ++q) { const float pv = part[q * 64 + dk]; btot += pv; if (dir == 0 ? q < cgp : q > cgp) off += pv; }
#pragma unroll
    for (int cc = 0; cc < 8; ++cc) bl[cc] += off;
}

static __device__ void gla_g3_item(const Params& p, unsigned char* shm, int l, int b, int h, int ci) {
    float* qf = (float*)shm;
    float* kf = qf + 4096;
    float* part = kf + 4096;
    bf16_t* VTs = (bf16_t*)(part + 1024);
    bf16_t* STs = VTs + 128 * 72;
    bf16_t* qt = STs + 2 * 128 * 72;
    bf16_t* kt = qt + 64 * 72;
    bf16_t* att = kt + 64 * 72;
    float* osh = qf;
    const int tid = tid_fresh(), wid = tid >> 6, lane = tid & 63, lq = lane & 15, g = lane >> 4, dk = tid & 63, cgp = tid >> 6;
    const size_t row0 = gla_row0(b, ci);
    gla_load_rope(p, tid, qf, row0, PC_QB + h * 64, ci, 0.125f);
    gla_load_rope(p, tid, kf, row0, PC_KB + h * 64, ci, 1.f);
    gla_load_vT(p, tid, VTs, row0, h);
    float* w2s = (float*)(att + 64 * 72);
    bf16_t* lrs = (bf16_t*)(w2s + 2048);
    gla_stage_gate(p, tid, w2s, lrs, l, h, row0);
#pragma unroll
    for (int dir = 0; dir < 2; ++dir) { const bf16_t* KVS = (const bf16_t*)(p.ws + WS_KVS) + ((size_t)((dir * 4 + b) * 4 + h) * NCHUNK + ci) * 8192;
#pragma unroll
        for (int q = 0; q < 2; ++q) { const int e8 = (q * 512 + tid) * 8; *(u32x4*)(STs + (dir * 128 + (e8 >> 6)) * 72 + (e8 & 63)) = *(const u32x4*)(KVS + e8); } }
    f32x4 oacc[4];
#pragma unroll
    for (int it = 0; it < 4; ++it) oacc[it] = (f32x4){0.f, 0.f, 0.f, 0.f};
    __syncthreads();
    float blv[2][8];
#pragma unroll
    for (int dir = 0; dir < 2; ++dir) part[(dir * 8 + cgp) * 64 + dk] = gla_g8(p, tid, w2s, lrs, l, h, dir, blv[dir]);
    __syncthreads();
#pragma unroll
    for (int dir = 0; dir < 2; ++dir) {
        float off = 0.f;
#pragma unroll
        for (int q = 0; q < 8; ++q) { const float pv = part[(dir * 8 + q) * 64 + dk]; if (dir == 0 ? q < cgp : q > cgp) off += pv; }
#pragma unroll
        for (int cc = 0; cc < 8; ++cc) { const int c = cgp * 8 + cc; const float bv = blv[dir][cc] + off; qt[c * 72 + dk] = f2bf(qf[c * 64 + dk] * __expf(bv)); kt[c * 72 + dk] = f2bf(kf[c * 64 + dk] * __expf(-bv)); }
        __syncthreads();
        { const int it = wid >> 1;
#pragma unroll
          for (int q = 0; q < 2; ++q) { const int jt = 2 * (wid & 1) + q; f32x4 a = {0.f, 0.f, 0.f, 0.f}; a = mma_lds(qt + (16 * it) * 72, 72, kt + (16 * jt) * 72, 72, 64, lq, g, a);
#pragma unroll
              for (int j = 0; j < 4; ++j) { const int i = 16 * it + 4 * g + j, jj = 16 * jt + lq; const bool keep = dir == 0 ? jj <= i : jj >= i; att[i * 72 + jj] = f2bf(keep ? a[j] : 0.f); } } }
        __syncthreads();
#pragma unroll
        for (int it = 0; it < 4; ++it) { oacc[it] = mma_lds(qt + (16 * it) * 72, 72, STs + (dir * 128 + 16 * wid) * 72, 72, 64, lq, g, oacc[it]);
            oacc[it] = mma_lds(att + (16 * it) * 72, 72, VTs + (16 * wid) * 72, 72, 64, lq, g, oacc[it]); }
        __syncthreads();
    }
    const bf16_t* P = (const bf16_t*)(p.ws + WS_P); bf16_t* CC = (bf16_t*)(p.ws + WS_ACT);
    unsigned zz[8];
#pragma unroll
    for (int q = 0; q < 8; ++q) { const size_t row = row0 + wid * 8 + q; zz[q] = *(const unsigned*)(P + row * PS + PC_ZB + h * 128 + 2 * lane); }
    const float gn0 = p.gla_norm[l * 128 + 2 * lane], gn1 = p.gla_norm[l * 128 + 2 * lane + 1];
#pragma unroll
    for (int it = 0; it < 4; ++it)
#pragma unroll
        for (int j = 0; j < 4; ++j) osh[(16 * it + 4 * g + j) * 128 + 16 * wid + lq] = oacc[it][j];
    __syncthreads();
#pragma unroll
    for (int q = 0; q < 8; ++q) { const int c = wid * 8 + q; const float o0 = osh[c * 128 + 2 * lane], o1 = osh[c * 128 + 2 * lane + 1];
        const float ms = wsum(o0 * o0 + o1 * o1) * (1.f / 128.f); const float rr = rsqrtf(ms + 1e-6f);
        const size_t row = row0 + c;
        *(unsigned*)(CC + row * D + 1024 + h * 128 + 2 * lane) = cvt_pk_bf16(o0 * rr * gn0 * silu_f(bflo(zz[q])), o1 * rr * gn1 * silu_f(bfhi(zz[q]))); }
    __syncthreads();
}

#ifndef ONLY
#define EN(k) 1
#else
#define EN(k) (ONLY==(k))
#endif
template <int SUB> __device__ __forceinline__ void run_sub(const Params& p, unsigned char* shm, const int l) {
    const int G = gridDim.x, bid = blockIdx.x;
    if constexpr (SUB == 0) {
        pg8::Gemm gm{(const bf16_t*)(p.ws + WS_ACT), (const bf16_t*)(p.ws + WS_WINT) + (size_t)l * NINP * D, MROWS, NINP, D};
        pg8::StaticOrder S; S.init(gm.M, gm.N, G, bid);
        EpiIn E{(bf16_t*)(p.ws + WS_P), (bf16_t*)(p.ws + WS_VT), (bf16_t*)(p.ws + WS_VTC), (bf16_t*)(p.ws + WS_KT)};
        pg8::gemm_phase<EpiIn>((LAS unsigned char*)shm, gm, S, E);
    } else if constexpr (SUB == 1) {
        for (int pi = bid; pi < 256; pi += G) na_pair(p, shm, l, pi);
        const int n_ca = l == 0 ? 256 : 0, n_cv = l == 0 ? 544 : 512, n_g1 = 16 * NCHUNK;
        const int total = n_ca + n_cv + n_g1;
        for (int it = bid; it < total; it += G) {
            int i = it;
            if (i < n_ca) { ctxattn_item(p, shm, i); continue; } i -= n_ca;
            if (i < n_cv) { conv_item(p, shm, l, i); continue; } i -= n_cv;
            gla_g1_item(p, shm, l, i);
        }
    } else if constexpr (SUB == 2) {
        for (int it = bid; it < 512; it += G) gla_scan_item(p, it);
    } else if constexpr (SUB == 3) {
        const int nch = l == 0 ? NCHUNK : 64, total = 16 * nch;
        for (int it = bid; it < total; it += G) { const int bh = it / nch, cix = it % nch; gla_g3_item(p, shm, l, bh >> 2, bh & 3, l == 0 ? cix : cix + 4); }
    } else if constexpr (SUB == 4) {
        pg8::Gemm gm{(const bf16_t*)(p.ws + WS_ACT), (const bf16_t*)(p.ws + WS_WOUTT) + (size_t)l * D * D, l == 0 ? MROWS : NLAT, D, D};
        pg8::StaticOrder S; S.init(gm.M, gm.N, G, bid);
        EpiOutY E{(bf16_t*)(p.ws + WS_Y)};
        pg8::gemm_phase<EpiOutY>((LAS unsigned char*)shm, gm, S, E);
        if (l == 0) convert_layer1_filler(p, shm);
    } else {
        phase_ln(p, l == 0 ? 1 : 2);
    }
}
#define XB_TMO      128
#define XB_XCNT(j)  (256  + 64 * (j))
#define XB_XSUB(j)  (1280 + 64 * (j))
#define XB_XGEN(j)  (2304 + 64 * (j))
#define XB_TOP      3328
#define XB_TOPGEN   3392
#define XB_SPIN_CAP (1u << 18)
__device__ __forceinline__ unsigned xb_ld(unsigned* p)              { return __hip_atomic_load(p, __ATOMIC_RELAXED, __HIP_MEMORY_SCOPE_AGENT); }
__device__ __forceinline__ unsigned xb_add(unsigned* p, unsigned v) { return __hip_atomic_fetch_add(p, v, __ATOMIC_RELAXED, __HIP_MEMORY_SCOPE_AGENT); }
__device__ __forceinline__ unsigned xb_xcc_id() { return (unsigned)__builtin_amdgcn_s_getreg((3 << 11) | 20) & 0xFu; }
#define XB_SPIN(cond, bar) do { unsigned _sp = 0; while (cond) { __builtin_amdgcn_s_sleep(1); \
    if ((++_sp & 255u) == 0u) { if (xb_ld(&(bar)[XB_TMO])) break; if (_sp > XB_SPIN_CAP) { atomicAdd(&(bar)[XB_TMO], 1u); break; } } } } while (0)
__device__ __forceinline__ void xcd_barrier_complete(unsigned* bar, unsigned x, unsigned& nloc, unsigned& nx) {
    const unsigned G = gridDim.x * gridDim.y * gridDim.z;
    unsigned sum, cnt, mine, sp = 0u;
    for (;;) {
        sum = 0u; cnt = 0u; mine = 0u;
#pragma unroll
        for (unsigned j = 0; j < 16; ++j) { const unsigned c = xb_ld(&bar[XB_XCNT(j)]); sum += c; cnt += (c > 0u) ? 1u : 0u; mine = (j == x) ? c : mine; }
        if (sum == G) break;
        __builtin_amdgcn_s_sleep(1);
        if ((++sp & 255u) == 0u) { if (xb_ld(&bar[XB_TMO])) break; if (sp > XB_SPIN_CAP) { atomicAdd(&bar[XB_TMO], 1u); break; } }
    }
    nloc = mine > 0u ? mine : 1u; nx = cnt > 0u ? cnt : 1u;
}
__device__ __forceinline__ void xcd_barrier(unsigned* bar, volatile LAS unsigned* st) {
    asm volatile("s_waitcnt vmcnt(0)" ::: "memory");
    __syncthreads();
    if (threadIdx.x == 0) {
        const unsigned x = xb_xcc_id();
        __builtin_amdgcn_s_waitcnt(0);
        unsigned nloc = st[0], nx = st[1];
        if (nloc == 0u) { xcd_barrier_complete(bar, x, nloc, nx); st[0] = nloc; st[1] = nx; }
        const unsigned old = xb_add(&bar[XB_XSUB(x)], 1u);
        const unsigned gen = old / nloc;
        if (old + 1u == (gen + 1u) * nloc) {
            __builtin_amdgcn_fence(__ATOMIC_RELEASE, "agent");
            asm volatile("s_waitcnt vmcnt(0)" ::: "memory");
            const unsigned og = xb_add(&bar[XB_TOP], 1u);
            const unsigned tg = og / nx;
            if (og + 1u == (tg + 1u) * nx) xb_add(&bar[XB_TOPGEN], 1u);
            else XB_SPIN(xb_ld(&bar[XB_TOPGEN]) == tg, bar);
            __builtin_amdgcn_fence(__ATOMIC_ACQUIRE, "agent");
            xb_add(&bar[XB_XGEN(x)], 1u);
            asm volatile("s_waitcnt vmcnt(0)" ::: "memory");
        } else {
            XB_SPIN(xb_ld(&bar[XB_XGEN(x)]) == gen, bar);
            __builtin_amdgcn_fence(__ATOMIC_ACQUIRE, "agent");
            asm volatile("s_waitcnt vmcnt(0)" ::: "memory");
        }
    }
    __syncthreads();
}

__device__ __forceinline__ unsigned long long ld_u64(const unsigned* lp, int i) {
    const unsigned lo = (unsigned)__builtin_amdgcn_readfirstlane((int)lp[2 * i]), hi = (unsigned)__builtin_amdgcn_readfirstlane((int)lp[2 * i + 1]);
    return ((unsigned long long)hi << 32) | lo;
}
#define GPTR(T, i) ((T*)(__attribute__((address_space(1))) T*)ld_u64(lp, (i)))
__device__ __forceinline__ void load_params(Params& q, unsigned char* shm) {
    const unsigned* lp = (const unsigned*)(shm + LDS_BYTES - 256);
    asm volatile("" : "+v"(lp) :: "memory");
    q.x = GPTR(const float, 0); q.c = GPTR(const float, 1); q.ctx = GPTR(const float, 2); q.c_ctx = GPTR(const float, 3);
    q.w_ada = GPTR(const float, 4); q.b_ada = GPTR(const float, 5); q.w_in = GPTR(const float, 6); q.rpb = GPTR(const float, 7);
    q.gla_w2 = GPTR(const float, 8); q.gla_b = GPTR(const float, 9); q.gla_norm = GPTR(const float, 10); q.conv_w = GPTR(const float, 11);
    q.conv_b = GPTR(const float, 12); q.conv_ln_g = GPTR(const float, 13); q.conv_ln_b = GPTR(const float, 14); q.w_out = GPTR(const float, 15);
    q.post_ln_g = GPTR(const float, 16); q.post_ln_b = GPTR(const float, 17); q.out = GPTR(float, 18); q.ws = GPTR(unsigned char, 19);
    q.ph_lo = 0; q.ph_hi = 0;
}
__global__ void __launch_bounds__(512, 2) fwd_megakernel(Params p) {
    extern __shared__ __attribute__((aligned(16))) unsigned char shm[];
    cg::grid_group grid = cg::this_grid();
    if (threadIdx.x < sizeof(Params) / 4) ((unsigned*)(shm + LDS_BYTES - 256))[threadIdx.x] = ((const unsigned*)&p)[threadIdx.x];
    volatile LAS unsigned* xst = (volatile LAS unsigned*)((LAS unsigned char*)shm + LDS_BYTES - 64);
    if (threadIdx.x == 0) { xst[0] = 0u; xst[1] = 0u; }
    __syncthreads();
    if (threadIdx.x == 0) (void)xb_add(&((unsigned*)(p.ws + WS_BAR))[XB_XCNT(xb_xcc_id())], 1u);
    const int ph_lo = p.ph_lo, ph_hi = p.ph_hi;
#ifndef REPMASK
#define REPMASK 0
#endif
#define GSYNC_CG() do { asm volatile("" ::: "memory"); grid.sync(); asm volatile("" ::: "memory"); } while (0)
#define GSYNC_X() do { unsigned* bar_ = (unsigned*)(__attribute__((address_space(1))) unsigned*)(ld_u64((const unsigned*)(shm + LDS_BYTES - 256), 19) + WS_BAR); xcd_barrier(bar_, xst); } while (0)
#define SEAM_X() do { const unsigned* lp_ = (const unsigned*)(shm + LDS_BYTES - 256); asm volatile("" : "+v"(lp_) :: "memory"); unsigned* bar_ = (unsigned*)(__attribute__((address_space(1))) unsigned*)(ld_u64(lp_, 19) + WS_BAR); xcd_barrier(bar_, xst); } while (0)
    { Params q; load_params(q, shm); phase_prep(q, shm); }
    if (ph_lo != 0) GSYNC_CG();
    SEAM_X();
    { Params q; load_params(q, shm); phase_ln(q, 0); }
#pragma unroll 1
    for (int l = 0; l < 2; ++l) {
        SEAM_X(); { Params q; load_params(q, shm); run_sub<0>(q, shm, l); }
        SEAM_X(); { Params q; load_params(q, shm); run_sub<1>(q, shm, l); }
        SEAM_X(); { Params q; load_params(q, shm); run_sub<2>(q, shm, l); }
        SEAM_X(); { Params q; load_params(q, shm); run_sub<3>(q, shm, l); }
        SEAM_X(); { Params q; load_params(q, shm); run_sub<4>(q, shm, l); }
        SEAM_X(); { Params q; load_params(q, shm); run_sub<5>(q, shm, l); }
    }
}

extern "C" void kernel_launch(void* const* d_in, const int* in_sizes, int n_in, void* d_out, int out_size, void* d_ws, size_t ws_size, hipStream_t stream) {
    static int grid = 0;
    if (grid == 0) {
        if (n_in != 18 || ws_size < WS_TOTAL) { fprintf(stderr, "kernel_launch: unexpected n_in %d / ws_size %zu (need %zu)\n", n_in, ws_size, (size_t)WS_TOTAL); grid = -1; return; }
        int dev = 0, cus = 0, per_cu = 0;
        hipGetDevice(&dev); hipDeviceGetAttribute(&cus, hipDeviceAttributeMultiprocessorCount, dev);
        if (hipFuncSetAttribute((const void*)fwd_megakernel, hipFuncAttributeMaxDynamicSharedMemorySize, LDS_BYTES) != hipSuccess) { fprintf(stderr, "kernel_launch: hipFuncSetAttribute failed\n"); grid = -1; return; }
        if (hipOccupancyMaxActiveBlocksPerMultiprocessor(&per_cu, (const void*)fwd_megakernel, 512, LDS_BYTES) != hipSuccess || per_cu < 1) { fprintf(stderr, "kernel_launch: occupancy query says %d blocks/CU\n", per_cu); per_cu = 1; }
        (void)hipGetLastError();
        grid = cus * 1;
        if (grid > 256) grid = 256;
    }
    if (grid < 0) return;
    if (hipMemsetAsync((unsigned char*)d_ws + WS_BAR, 0, (size_t)XCD_BAR_WORDS * 4, stream) != hipSuccess) { fprintf(stderr, "kernel_launch: hipMemsetAsync of the barrier words failed\n"); return; }
    Params p{};
    const float** pp = (const float**)&p;
    for (int i = 0; i < 18; ++i) pp[i] = (const float*)d_in[i];
    p.out = (float*)d_out; p.ws = (unsigned char*)d_ws; p.ph_lo = 0; p.ph_hi = 14;
    void* args[] = {&p};
    hipError_t e = hipLaunchCooperativeKernel((const void*)fwd_megakernel, dim3(grid), dim3(512), args, LDS_BYTES, stream);
    if (e != hipSuccess) fprintf(stderr, "cooperative launch failed: %s (grid %d)\n", hipGetErrorString(e), grid);
}
```

```cpp
#include <hip/hip_runtime.h>
#include <hip/hip_cooperative_groups.h>
#include <cstdio>
namespace cg = cooperative_groups;

#define LAS __attribute__((address_space(3)))
typedef unsigned short bf16_t;
typedef short bf16x8 __attribute__((ext_vector_type(8)));
typedef float f32x4 __attribute__((ext_vector_type(4)));
typedef unsigned u32x4 __attribute__((ext_vector_type(4)));
typedef unsigned u32x2 __attribute__((ext_vector_type(2)));

constexpr int D = 2048, SEQ = 4096, LC = 256, NLAT = 16384, MROWS = 17408;
constexpr int NIN = 7200, NINP = 7424, PS = 6208;
constexpr int PC_QA = 0, PC_KA = 1024, PC_ZA = 2048, PC_QB = 3072, PC_KB = 3328, PC_VB = 3584, PC_ZB = 4096, PC_GLR = 4608, PC_CA = 4640, PC_CG = 5152, PC_ZC = 5664;
constexpr int NCHUNK = 68;
constexpr float ALPHA = 1.4142135623730951f;
constexpr size_t WS_WINT = 0;
constexpr size_t WS_WOUTT = WS_WINT + (size_t)2 * NINP * D * 2;
constexpr size_t WS_MOD = WS_WOUTT + (size_t)2 * D * D * 2;
constexpr size_t WS_ROPE = WS_MOD + (size_t)2 * 5 * 6144 * 4;
constexpr size_t WS_ACT = WS_ROPE + 8192;
constexpr size_t WS_P = WS_ACT + (size_t)MROWS * D * 2;
constexpr size_t WS_VT = WS_P + (size_t)MROWS * PS * 2;
constexpr size_t WS_VTC = WS_VT + (size_t)4 * 16 * 64 * 4096 * 2;
constexpr size_t WS_KVT = WS_VTC + (size_t)4 * 16 * 64 * 256 * 2;
constexpr size_t WS_DEC = WS_KVT + (size_t)2 * 16 * NCHUNK * 8192 * 4;
constexpr size_t WS_XC = WS_DEC + (size_t)2 * 16 * NCHUNK * 64 * 4;
constexpr size_t WS_KVS = WS_XC + (size_t)1024 * D * 4;
constexpr size_t WS_Y = WS_KVT;
constexpr size_t WS_KT = WS_KVS;
constexpr size_t WS_END = WS_KVS + (size_t)2 * 16 * NCHUNK * 8192 * 2;
constexpr size_t WS_BAR = (WS_END + 255) & ~(size_t)255;
constexpr int XCD_BAR_WORDS = 3456;
constexpr size_t WS_TOTAL = WS_BAR + (size_t)XCD_BAR_WORDS * 4;
constexpr int LDS_BYTES = 147456;

struct Params {
    const float *x, *c, *ctx, *c_ctx, *w_ada, *b_ada, *w_in, *rpb, *gla_w2, *gla_b, *gla_norm, *conv_w, *conv_b, *conv_ln_g, *conv_ln_b, *w_out, *post_ln_g, *post_ln_b;
    float* out; unsigned char* ws; int ph_lo, ph_hi;
};

typedef float f32x2_t __attribute__((ext_vector_type(2)));
typedef __bf16 bf16x2_t __attribute__((ext_vector_type(2)));
__device__ __forceinline__ unsigned cvt_pk_bf16(float lo, float hi) { const f32x2_t v = {lo, hi}; return __builtin_bit_cast(unsigned, __builtin_convertvector(v, bf16x2_t)); }
__device__ __forceinline__ bf16_t f2bf(float f) { return (bf16_t)(cvt_pk_bf16(f, 0.f) & 0xffffu); }
__device__ __forceinline__ float bf2f(bf16_t v) { return __uint_as_float(((unsigned)v) << 16); }
__device__ __forceinline__ float bflo(unsigned w) { return __uint_as_float(w << 16); }
__device__ __forceinline__ float bfhi(unsigned w) { return __uint_as_float(w & 0xffff0000u); }
__device__ __forceinline__ void unpack8(u32x4 w, float (&f)[8]) {
    f[0] = bflo(w[0]); f[1] = bfhi(w[0]); f[2] = bflo(w[1]); f[3] = bfhi(w[1]); f[4] = bflo(w[2]); f[5] = bfhi(w[2]); f[6] = bflo(w[3]); f[7] = bfhi(w[3]);
}
__device__ __forceinline__ u32x4 pack8(const float (&f)[8]) { u32x4 w; w[0] = cvt_pk_bf16(f[0], f[1]); w[1] = cvt_pk_bf16(f[2], f[3]); w[2] = cvt_pk_bf16(f[4], f[5]); w[3] = cvt_pk_bf16(f[6], f[7]); return w; }
__device__ __forceinline__ float silu_f(float x) { return x * __builtin_amdgcn_rcpf(1.f + __expf(-x)); }
__device__ __forceinline__ float sigm_f(float x) { return __builtin_amdgcn_rcpf(1.f + __expf(-x)); }
__device__ __forceinline__ float wsum(float v) {
#define WS_DPP(x, ctrl) __builtin_bit_cast(float, __builtin_amdgcn_update_dpp(0, __builtin_bit_cast(int, (x)), (ctrl), 0xF, 0xF, true))
    v += WS_DPP(v, 0xB1); v += WS_DPP(v, 0x4E); v += WS_DPP(v, 0x141); v += WS_DPP(v, 0x140);
#undef WS_DPP
    const int vi = __builtin_bit_cast(int, v);
    return (__builtin_bit_cast(float, __builtin_amdgcn_readlane(vi, 0)) + __builtin_bit_cast(float, __builtin_amdgcn_readlane(vi, 16)))
         + (__builtin_bit_cast(float, __builtin_amdgcn_readlane(vi, 32)) + __builtin_bit_cast(float, __builtin_amdgcn_readlane(vi, 48)));
}
__device__ __forceinline__ int tid_fresh() { int t = threadIdx.x; asm volatile("" : "+v"(t)); return t; }
__device__ __forceinline__ f32x4 mfma16(bf16x8 a, bf16x8 b, f32x4 c) { return __builtin_amdgcn_mfma_f32_16x16x32_bf16(a, b, c, 0, 0, 0); }

namespace pg8 {
constexpr int BM = 256, BK = 64, HALF = 128, HTB = HALF * BK * 2, STAGE_BYTES = 8 * HTB, NXCD = 8, WGM = 8;
__host__ __device__ __forceinline__ int lds_byte(int r, int c) { const int st = (r >> 4) * 2 + (c >> 5), rr = r & 15, cc = c & 31, ob = rr * 64 + cc * 2; return st * 1024 + (ob ^ (((ob >> 9) & 1) << 5)); }
__host__ __device__ __forceinline__ void stage_rc(int b, int& R, int& C) { const int st = b / 1024, sb = b % 1024, swz = sb ^ (((sb >> 9) & 1) << 5); R = (st >> 1) * 16 + swz / 64; C = (st & 1) * 32 + (swz % 64) / 2; }
__host__ __device__ __forceinline__ int perm32(int rho) { const int n = rho >> 4, i = rho & 15; return 8 * (i >> 2) + 4 * n + (i & 3); }
struct Unit { int pm, pn; };
struct Gemm { const bf16_t* A; const bf16_t* Bt; int M, N, K; };
struct StaticOrder {
    int nM, nN, nwg, G, c;
    __host__ __device__ void init(int M, int N, int G_, int c_) { nM = M / BM; nN = N / BM; nwg = nM * nN; G = G_; c = c_; }
    __host__ __device__ bool next(int i, Unit& u) const {
        const long L = (long)i * G + c; if (L >= nwg) return false;
        int wgid = (int)L; { const int q = nwg / NXCD, r = nwg % NXCD, xcd = wgid % NXCD, off = wgid / NXCD; wgid = (xcd < r ? xcd * (q + 1) : r * (q + 1) + (xcd - r) * q) + off; }
        const int nig = WGM * nN, gid = wgid / nig, fm = gid * WGM, gsz = (nM - fm) < WGM ? (nM - fm) : WGM;
        u.pm = fm + ((wgid % nig) % gsz); u.pn = (wgid % nig) / gsz; return true;
    }
};

template <class Epi>
__device__ __forceinline__ void gemm_phase(LAS unsigned char* lds, const Gemm g, const StaticOrder& S, const Epi& E) {
    const int tid = tid_fresh(), wid = __builtin_amdgcn_readfirstlane(tid >> 6), lane = tid & 63, wr = wid >> 2, wc = wid & 3, fr = lane & 15, fq = lane >> 4;
    const int K = g.K, nt = K / BK;
    unsigned voffA[2], voffB[2];
#pragma unroll
    for (int i = 0; i < 2; ++i) { int R, C; stage_rc(tid * 16 + i * 8192, R, C); const int Rb = Epi::PERM ? ((R & ~31) + perm32(R & 31)) : R;
        voffA[i] = (unsigned)(R * K + C) * 2u; voffB[i] = (unsigned)(Rb * K + C) * 2u; }
    const size_t kstep = (size_t)(BK * 2);
    const size_t hstep = (size_t)HALF * K * 2;
    const size_t tstep = 2 * hstep;
    const unsigned ldsw = (unsigned)wid * 1024u;
    const int aoff = lds_byte(wr * 64 + fr, fq * 8), boff = lds_byte(wc * 32 + fr, fq * 8);
#define PG8_SA(b, h) (((b) * 2 + (h)) * HTB)
#define PG8_SB(b, h) ((4 + (b) * 2 + (h)) * HTB)
#define PG8_STAGE(bufoff, gbase, voff) do { _Pragma("unroll") for (int _i = 0; _i < 2; ++_i) \
        __builtin_amdgcn_global_load_lds((const unsigned*)((const char*)(gbase) + (voff)[_i]), (LAS unsigned*)(lds + (bufoff) + ldsw + _i * 8192), 16, 0, 0); } while (0)
#define PG8_LDA(dst, b, h) do { _Pragma("unroll") for (int m = 0; m < 4; ++m) _Pragma("unroll") for (int k = 0; k < 2; ++k) dst[m][k] = *(const LAS bf16x8*)(lds + PG8_SA(b, h) + aoff + m * 2048 + k * 1024); } while (0)
#define PG8_LDB(dst, b, h) do { _Pragma("unroll") for (int n = 0; n < 2; ++n) _Pragma("unroll") for (int k = 0; k < 2; ++k) dst[n][k] = *(const LAS bf16x8*)(lds + PG8_SB(b, h) + boff + n * 2048 + k * 1024); } while (0)
#define PG8_MMA(ai, bj, At, Bt) do { __builtin_amdgcn_s_setprio(1); _Pragma("unroll") for (int m = 0; m < 4; ++m) _Pragma("unroll") for (int n = 0; n < 2; ++n) _Pragma("unroll") for (int k = 0; k < 2; ++k) \
        acc[ai][bj][m][n] = __builtin_amdgcn_mfma_f32_16x16x32_bf16(Bt[n][k], At[m][k], acc[ai][bj][m][n], 0, 0, 0); __builtin_amdgcn_s_setprio(0); } while (0)
#define PG8_WAIT_V(n) asm volatile("s_waitcnt vmcnt(" #n ")" ::: "memory")
#define PG8_WAIT_L(n) asm volatile("s_waitcnt lgkmcnt(" #n ")" ::: "memory")
#define PG8_BAR __builtin_amdgcn_s_barrier()
#define PG8_SCHED __builtin_amdgcn_sched_barrier(0)
    Unit cur, nxt; int ui = 0;
    if (!S.next(0, cur)) return;
    f32x4 acc[2][2][4][2];
#pragma unroll
    for (int a = 0; a < 2; ++a)
#pragma unroll
        for (int b = 0; b < 2; ++b)
#pragma unroll
            for (int m = 0; m < 4; ++m)
#pragma unroll
                for (int n = 0; n < 2; ++n) acc[a][b][m][n] = (f32x4){0.f, 0.f, 0.f, 0.f};
    bf16x8 At[4][2], B0[2][2], B1[2][2];
    const char* cA = (const char*)g.A + (size_t)cur.pm * tstep; const char* cB = (const char*)g.Bt + (size_t)cur.pn * tstep;
    PG8_STAGE(PG8_SB(0, 0), cB, voffB); PG8_STAGE(PG8_SA(0, 0), cA, voffA); PG8_STAGE(PG8_SB(0, 1), cB + hstep, voffB); PG8_STAGE(PG8_SA(0, 1), cA + hstep, voffA);
    if (wr == 1) PG8_BAR;
    PG8_WAIT_V(4); PG8_BAR;
    PG8_STAGE(PG8_SB(1, 0), cB + kstep, voffB); PG8_STAGE(PG8_SA(1, 0), cA + kstep, voffA); PG8_STAGE(PG8_SB(1, 1), cB + hstep + kstep, voffB);
    PG8_WAIT_V(6); PG8_BAR;
    for (;;) {
        const bool has_next = S.next(ui + 1, nxt);
        const char* nA = has_next ? (const char*)g.A + (size_t)nxt.pm * tstep : cA; const char* nB = has_next ? (const char*)g.Bt + (size_t)nxt.pn * tstep : cB;
        for (int t = 0; t < nt; t += 2) {
            const bool last = (t == nt - 2);
            const char* a1 = cA + (size_t)(t + 1) * kstep;
            const char* a2 = last ? nA : cA + (size_t)(t + 2) * kstep; const char* b2 = last ? nB : cB + (size_t)(t + 2) * kstep;
            const char* a3 = a2 + kstep; const char* b3 = b2 + kstep;
            PG8_LDB(B0, 0, 0); PG8_SCHED; PG8_LDA(At, 0, 0); PG8_STAGE(PG8_SA(1, 1), a1 + hstep, voffA);
            PG8_WAIT_L(8); PG8_BAR; PG8_WAIT_L(0); PG8_MMA(0, 0, At, B0); PG8_BAR; PG8_SCHED;
            PG8_LDB(B1, 0, 1); PG8_STAGE(PG8_SB(0, 0), b2, voffB);
            PG8_BAR; PG8_WAIT_L(0); PG8_MMA(0, 1, At, B1); PG8_BAR;
            PG8_LDA(At, 0, 1); PG8_STAGE(PG8_SA(0, 0), a2, voffA);
            PG8_BAR; PG8_WAIT_L(0); PG8_MMA(1, 0, At, B0); PG8_BAR; PG8_SCHED;
            PG8_STAGE(PG8_SB(0, 1), b2 + hstep, voffB);
            PG8_WAIT_V(6); PG8_BAR; PG8_MMA(1, 1, At, B1); PG8_BAR;
            PG8_LDB(B0, 1, 0); PG8_SCHED; PG8_LDA(At, 1, 0); PG8_STAGE(PG8_SA(0, 1), a2 + hstep, voffA);
            PG8_WAIT_L(8); PG8_BAR; PG8_WAIT_L(0); PG8_MMA(0, 0, At, B0); PG8_BAR; PG8_SCHED;
            PG8_LDB(B1, 1, 1); PG8_STAGE(PG8_SB(1, 0), b3, voffB);
            PG8_BAR; PG8_WAIT_L(0); PG8_MMA(0, 1, At, B1); PG8_BAR;
            PG8_LDA(At, 1, 1); PG8_STAGE(PG8_SA(1, 0), a3, voffA);
            PG8_BAR; PG8_WAIT_L(0); PG8_MMA(1, 0, At, B0); PG8_BAR; PG8_SCHED;
            PG8_STAGE(PG8_SB(1, 1), b3 + hstep, voffB);
            PG8_WAIT_V(6); PG8_BAR; PG8_MMA(1, 1, At, B1); PG8_BAR;
        }
        E(acc, cur, wr, wc, fr, fq);
        if (!has_next) break;
#pragma unroll
        for (int a = 0; a < 2; ++a)
#pragma unroll
            for (int b = 0; b < 2; ++b)
#pragma unroll
                for (int m = 0; m < 4; ++m)
#pragma unroll
                    for (int n = 0; n < 2; ++n) acc[a][b][m][n] = (f32x4){0.f, 0.f, 0.f, 0.f};
        cur = nxt; cA = nA; cB = nB; ++ui;
    }
    PG8_WAIT_V(0);
    if (wr == 0) PG8_BAR;
    PG8_BAR;
#undef PG8_SA
#undef PG8_SB
#undef PG8_STAGE
#undef PG8_LDA
#undef PG8_LDB
#undef PG8_MMA
#undef PG8_WAIT_V
#undef PG8_WAIT_L
#undef PG8_BAR
#undef PG8_SCHED
}
}

struct EpiIn {
    static constexpr bool PERM = true;
    bf16_t* P; bf16_t* VT; bf16_t* VTC; bf16_t* KT;
    __device__ __forceinline__ void operator()(const f32x4 (&acc)[2][2][4][2], const pg8::Unit& u, int wr, int wc, int fr, int fq) const {
        const int row0 = u.pm * 256 + wr * 64 + fr;
        if (u.pn >= 8 && u.pn < 12) {
            const int c0 = (u.pn - 8) * 256 + wc * 32 + 8 * fq;
            if (u.pm < 64) {
                const int b = u.pm >> 4, t0 = row0 - b * 4096;
#pragma unroll
                for (int ai = 0; ai < 2; ++ai)
#pragma unroll
                    for (int m = 0; m < 4; ++m) { const int t = t0 + ai * 128 + m * 16;
#pragma unroll
                        for (int bj = 0; bj < 2; ++bj)
#pragma unroll
                            for (int n = 0; n < 2; ++n)
#pragma unroll
                                for (int j = 0; j < 4; ++j) { const int c = c0 + bj * 128 + 4 * n + j;
                                    VT[((((size_t)(b * 16 + (c >> 6)) * 512 + (t >> 3)) * 64 + (((c & 3) << 4) | ((c & 63) >> 2))) << 3) + (t & 7)] = f2bf(acc[ai][bj][m][n][j]); } }
            } else {
                const int b = u.pm - 64, t0 = row0 - NLAT - b * 256; bf16_t* base = VTC + (size_t)b * 1024 * 256;
#pragma unroll
                for (int ai = 0; ai < 2; ++ai)
#pragma unroll
                    for (int m = 0; m < 4; ++m) { const int t = t0 + ai * 128 + m * 16;
#pragma unroll
                        for (int bj = 0; bj < 2; ++bj)
#pragma unroll
                            for (int n = 0; n < 2; ++n)
#pragma unroll
                                for (int j = 0; j < 4; ++j) { const int c = c0 + bj * 128 + 4 * n + j; base[(size_t)((c & ~63) | ((c & 3) << 4) | ((c & 63) >> 2)) * 256 + t] = f2bf(acc[ai][bj][m][n][j]); } }
            }
        } else {
            const bool ktile = u.pn >= 4 && u.pn < 8 && u.pm < 64;
            const int cdst0 = u.pn * 256 - (u.pn >= 12 ? 1024 : 0) + wc * 32 + 8 * fq;
            const int ck0 = (u.pn - 4) * 256 + wc * 32 + 8 * fq, bb = u.pm >> 4;
#pragma unroll
            for (int ai = 0; ai < 2; ++ai)
#pragma unroll
                for (int m = 0; m < 4; ++m) { const int row = row0 + ai * 128 + m * 16; bf16_t* rowp = P + (size_t)row * PS + cdst0; const int t = row - bb * 4096;
#pragma unroll
                    for (int bj = 0; bj < 2; ++bj) if (u.pn < 28 || (bj == 0 && wc == 0)) {
                        const f32x4 v0 = acc[ai][bj][m][0], v1 = acc[ai][bj][m][1]; u32x4 w;
                        w[0] = cvt_pk_bf16(v0[0], v0[1]); w[1] = cvt_pk_bf16(v0[2], v0[3]); w[2] = cvt_pk_bf16(v1[0], v1[1]); w[3] = cvt_pk_bf16(v1[2], v1[3]);
                        bf16_t* dst = rowp + bj * 128;
                        if (ktile) { const int ck = ck0 + bj * 128, hh = ck >> 6, dim0 = ck & 63;
                            dst = KT + ((((((size_t)(bb * 16 + hh) * 1024 + (t >> 2)) * 2 + (dim0 >> 5)) * 4 + (t & 3)) << 5) + (dim0 & 31)); }
                        *(u32x4*)dst = w; } }
        }
    }
};
struct EpiOut {
    static constexpr bool PERM = false;
    const float* xlat; const float* xctx; float* olat; float* octx; const float* gate;
    __device__ __forceinline__ void operator()(const f32x4 (&acc)[2][2][4][2], const pg8::Unit& u, int wr, int wc, int fr, int fq) const {
        const int row0 = u.pm * 256 + wr * 64 + fr, col0 = u.pn * 256 + wc * 32 + 4 * fq;
#pragma unroll
        for (int ai = 0; ai < 2; ++ai)
#pragma unroll
            for (int m = 0; m < 4; ++m) { const int row = row0 + ai * 128 + m * 16; const float* xs; float* od; int mr;
                if (row < NLAT) { xs = xlat + (size_t)row * D; od = olat + (size_t)row * D; mr = row >> 12; } else { xs = xctx + (size_t)(row - NLAT) * D; od = octx + (size_t)(row - NLAT) * D; mr = 4; }
#pragma unroll
                for (int bj = 0; bj < 2; ++bj)
#pragma unroll
                    for (int n = 0; n < 2; ++n) { const int c = col0 + bj * 128 + n * 16;
                        const f32x4 xv = *(const f32x4*)(xs + c), gv = *(const f32x4*)(gate + mr * 6144 + c);
                        *(f32x4*)(od + c) = xv * ALPHA + gv * acc[ai][bj][m][n]; } }
    }
};

struct EpiOutY {
    static constexpr bool PERM = true;
    bf16_t* Y;
    __device__ __forceinline__ void operator()(const f32x4 (&acc)[2][2][4][2], const pg8::Unit& u, int wr, int wc, int fr, int fq) const {
        const int row0 = u.pm * 256 + wr * 64 + fr, c0 = u.pn * 256 + wc * 32 + 8 * fq;
#pragma unroll
        for (int ai = 0; ai < 2; ++ai)
#pragma unroll
            for (int m = 0; m < 4; ++m) { bf16_t* rowp = Y + (size_t)(row0 + ai * 128 + m * 16) * D + c0;
#pragma unroll
                for (int bj = 0; bj < 2; ++bj) { const f32x4 v0 = acc[ai][bj][m][0], v1 = acc[ai][bj][m][1]; u32x4 w;
                    w[0] = cvt_pk_bf16(v0[0], v0[1]); w[1] = cvt_pk_bf16(v0[2], v0[3]); w[2] = cvt_pk_bf16(v1[0], v1[1]); w[3] = cvt_pk_bf16(v1[2], v1[3]);
                    *(u32x4*)(rowp + bj * 128) = w; } }
    }
};

__device__ __forceinline__ void transpose_tile(const float* __restrict__ src, int N, bf16_t* __restrict__ dst, int kt, int nt, float* tile) {
    const int tid = tid_fresh(), k0 = kt * 64, n0 = nt * 256, wid = tid >> 6, nc = (tid & 63) * 4;
    f32x4 v[8];
#pragma unroll
    for (int i = 0; i < 8; ++i) { v[i] = (f32x4){0.f, 0.f, 0.f, 0.f}; if (n0 + nc < N) v[i] = *(const f32x4*)(src + (size_t)(k0 + wid + 8 * i) * N + n0 + nc); }
#pragma unroll
    for (int i = 0; i < 8; ++i) { float* tp = tile + (wid + 8 * i) * 257 + nc; tp[0] = v[i][0]; tp[1] = v[i][1]; tp[2] = v[i][2]; tp[3] = v[i][3]; }
    __syncthreads();
    { const int n = tid >> 1, ks = (tid & 1) * 32;
#pragma unroll
      for (int q = 0; q < 4; ++q) { float f[8];
#pragma unroll
          for (int e = 0; e < 8; ++e) f[e] = tile[(ks + q * 8 + e) * 257 + n];
          *(u32x4*)(dst + (size_t)(n0 + n) * D + k0 + ks + q * 8) = pack8(f); } }
    __syncthreads();
}

static __device__ void phase_prep(const Params& p, unsigned char* shm) {
    float* sl = (float*)shm; const int tid = tid_fresh();
    if (blockIdx.x == gridDim.x - 1) {
        float* rope = (float*)(p.ws + WS_ROPE);
        for (int e = tid; e < 1024; e += 512) { const int pos = e >> 4, i = e & 15; const float inv = exp2f(-(float)i * (13.287712379549449f / 16.f)); const float ang = (float)pos * inv;
            rope[e] = cosf(ang); rope[1024 + e] = sinf(ang); }
    }
    constexpr int NG = 192, TIN = 29 * 32, TOUT = 8 * 32, TOTAL = NG + (TIN + TOUT);
    for (int it = blockIdx.x; it < TOTAL; it += gridDim.x) {
        if (it < NG) {
            const int l = it / 96, n0 = (it % 96) * 64;
            for (int e = tid; e < 5 * 2048; e += 512) { const float v = e < 4 * 2048 ? p.c[e] : p.c_ctx[e - 4 * 2048]; sl[e] = silu_f(v); }
            __syncthreads();
            const int cq = tid & 15, ks = tid >> 4; float acc[5][4];
#pragma unroll
            for (int r = 0; r < 5; ++r)
#pragma unroll
                for (int e = 0; e < 4; ++e) acc[r][e] = 0.f;
            const float* W = p.w_ada + (size_t)l * 2048 * 6144 + n0 + 4 * cq;
#pragma unroll 8
            for (int kk = 0; kk < 64; ++kk) { const int k = ks * 64 + kk; const f32x4 w = *(const f32x4*)(W + (size_t)k * 6144);
#pragma unroll
                for (int r = 0; r < 5; ++r) { const float sv = sl[r * 2048 + k]; acc[r][0] += sv * w[0]; acc[r][1] += sv * w[1]; acc[r][2] += sv * w[2]; acc[r][3] += sv * w[3]; } }
            float* red = sl + 10240;
#pragma unroll
            for (int r = 0; r < 5; ++r)
#pragma unroll
                for (int e = 0; e < 4; ++e) red[(ks * 5 + r) * 64 + 4 * cq + e] = acc[r][e];
            __syncthreads();
            if (tid < 320) { const int r = tid >> 6, col = tid & 63; float s = 0.f;
                for (int q = 0; q < 32; ++q) s += red[(q * 5 + r) * 64 + col];
                ((float*)(p.ws + WS_MOD))[(size_t)(l * 5 + r) * 6144 + n0 + col] = s + p.b_ada[(size_t)l * 6144 + n0 + col]; }
            __syncthreads();
        } else {
            int idx = it - NG; const int l = 0;
            if (idx < TIN) transpose_tile(p.w_in + (size_t)l * D * NIN, NIN, (bf16_t*)(p.ws + WS_WINT) + (size_t)l * NINP * D, idx & 31, idx >> 5, sl);
            else { idx -= TIN; transpose_tile(p.w_out + (size_t)l * D * D, D, (bf16_t*)(p.ws + WS_WOUTT) + (size_t)l * D * D, idx & 31, idx >> 5, sl); }
        }
    }
}

static __device__ void convert_layer1_filler(const Params& p, unsigned char* shm) {
    constexpr int TIN = 29 * 32, TOUT = 8 * 32, FIRST = 32;
    float* sl = (float*)shm;
    const int nb = (int)gridDim.x > FIRST ? (int)gridDim.x - FIRST : (int)gridDim.x, b0 = (int)gridDim.x > FIRST ? (int)blockIdx.x - FIRST : (int)blockIdx.x;
    if (b0 < 0) return;
    for (int idx = b0; idx < TIN + TOUT; idx += nb) {
        if (idx < TIN) transpose_tile(p.w_in + (size_t)D * NIN, NIN, (bf16_t*)(p.ws + WS_WINT) + (size_t)NINP * D, idx & 31, idx >> 5, sl);
        else { const int j = idx - TIN; transpose_tile(p.w_out + (size_t)D * D, D, (bf16_t*)(p.ws + WS_WOUTT) + (size_t)D * D, j & 31, j >> 5, sl); }
    }
}

static __device__ void phase_ln(const Params& p, int mode) {
    const int tid_ = tid_fresh(), lane = tid_ & 63, wid = tid_ >> 6;
    const int nrows = mode == 2 ? NLAT : MROWS;
    const float* mod = (const float*)(p.ws + WS_MOD) + (mode == 1 ? 5 * 6144 : 0);
    bf16_t* H = (bf16_t*)(p.ws + WS_ACT);
    float* XC = (float*)(p.ws + WS_XC);
    const int lpost = mode == 1 ? 0 : 1;
    int nw = gridDim.x * 8; asm volatile("" : "+s"(nw));
    for (int rowa = blockIdx.x * 8 + wid; rowa < nrows; rowa += 2 * nw) {
        int rows[2] = {rowa, rowa + nw}; const bool ok1 = rows[1] < nrows; if (!ok1) rows[1] = rowa;
        float* rp[2]; const float* sp[2]; f32x4 v[2][8]; float s[2], mu[2], q[2], rstd[2];
#pragma unroll
        for (int k = 0; k < 2; ++k) { const int row = rows[k];
            if (row < NLAT) { rp[k] = p.out + (size_t)row * D; sp[k] = mode == 2 ? rp[k] : p.x + (size_t)row * D; }
            else { rp[k] = XC + (size_t)(row - NLAT) * D; sp[k] = p.ctx + (size_t)(row - NLAT) * D; } }
#pragma unroll
        for (int k = 0; k < 2; ++k) { s[k] = 0.f;
            const bf16_t* yp = (const bf16_t*)(p.ws + WS_Y) + (size_t)rows[k] * D;
            const float* gp = (const float*)(p.ws + WS_MOD) + (size_t)lpost * 5 * 6144 + 4096 + (rows[k] < NLAT ? rows[k] >> 12 : 4) * 6144;
#pragma unroll
            for (int i = 0; i < 8; ++i) { const int c = (i * 64 + lane) * 4; v[k][i] = *(const f32x4*)(sp[k] + c);
                if (mode != 0) { const u32x2 yw = *(const u32x2*)(yp + c); const f32x4 gv = *(const f32x4*)(gp + c);
                    const f32x4 yv = {bflo(yw[0]), bfhi(yw[0]), bflo(yw[1]), bfhi(yw[1])}; v[k][i] = v[k][i] * ALPHA + gv * yv; }
                s[k] += v[k][i][0] + v[k][i][1] + v[k][i][2] + v[k][i][3]; } }
#pragma unroll
        for (int k = 0; k < 2; ++k) { mu[k] = wsum(s[k]) * (1.f / 2048.f); q[k] = 0.f;
#pragma unroll
            for (int i = 0; i < 8; ++i) { v[k][i] = v[k][i] - mu[k]; q[k] += v[k][i][0] * v[k][i][0] + v[k][i][1] * v[k][i][1] + v[k][i][2] * v[k][i][2] + v[k][i][3] * v[k][i][3]; } }
#pragma unroll
        for (int k = 0; k < 2; ++k) rstd[k] = rsqrtf(wsum(q[k]) * (1.f / 2048.f) + 1e-5f);
        if (mode != 0) {
#pragma unroll
            for (int k = 0; k < 2; ++k) { s[k] = 0.f;
#pragma unroll
                for (int i = 0; i < 8; ++i) { const int c = (i * 64 + lane) * 4; const f32x4 gg = *(const f32x4*)(p.post_ln_g + lpost * D + c), bb = *(const f32x4*)(p.post_ln_b + lpost * D + c);
                    v[k][i] = v[k][i] * rstd[k] * gg + bb; if ((k == 0 || ok1) && rows[k] < NLAT) *(f32x4*)(rp[k] + c) = v[k][i]; s[k] += v[k][i][0] + v[k][i][1] + v[k][i][2] + v[k][i][3]; } }
            if (mode == 2) continue;
#pragma unroll
            for (int k = 0; k < 2; ++k) { mu[k] = wsum(s[k]) * (1.f / 2048.f); q[k] = 0.f;
#pragma unroll
                for (int i = 0; i < 8; ++i) { v[k][i] = v[k][i] - mu[k]; q[k] += v[k][i][0] * v[k][i][0] + v[k][i][1] * v[k][i][1] + v[k][i][2] * v[k][i][2] + v[k][i][3] * v[k][i][3]; } }
#pragma unroll
            for (int k = 0; k < 2; ++k) rstd[k] = rsqrtf(wsum(q[k]) * (1.f / 2048.f) + 1e-5f);
        }
#pragma unroll
        for (int k = 0; k < 2; ++k) { if (k == 1 && !ok1) break; const int row = rows[k]; const int mr = row < NLAT ? row >> 12 : 4; const float* mrow = mod + mr * 6144;
#pragma unroll
            for (int i = 0; i < 8; ++i) { const int c = (i * 64 + lane) * 4; const f32x4 sh = *(const f32x4*)(mrow + c), sc = *(const f32x4*)(mrow + 2048 + c);
                const f32x4 h = v[k][i] * rstd[k] * (sc + 1.f) + sh; u32x2 w; w[0] = cvt_pk_bf16(h[0], h[1]); w[1] = cvt_pk_bf16(h[2], h[3]);
                *(u32x2*)(H + (size_t)row * D + c) = w; } }
    }
}

__device__ __forceinline__ bf16x8 ldx8(const bf16_t* p) { return *(const bf16x8*)p; }
__device__ __forceinline__ bf16x8 ldx8(const LAS bf16_t* p) { return *(const LAS bf16x8*)p; }
template <int NB, bool LOCAL, int KLD, class KP, class VP>
__device__ __forceinline__ void attn_part(const bf16_t* __restrict__ qrow, KP kbase, size_t kblk_stride, VP vtbase, int vt_ld, int vblk_stride,
                                          const float* rpbs, int drow0, int kc0, int qc, int lq, int g, float& m_out, float& l_out, f32x4 (&O)[4]) {
    bf16x8 qf[2];
    qf[0] = *(const bf16x8*)(qrow + 8 * g); qf[1] = *(const bf16x8*)(qrow + 32 + 8 * g);
    f32x4 S[NB][2];
    const int krow = 8 * (lq >> 2) + (lq & 3);
#pragma unroll
    for (int kb = 0; kb < NB; ++kb) {
        auto kp = kbase + (size_t)kb * kblk_stride + (size_t)krow * KLD + 8 * g;
#pragma unroll
        for (int tt = 0; tt < 2; ++tt) { auto kp2 = kp + (size_t)tt * 4 * KLD;
            const bf16x8 k0 = ldx8(kp2), k1 = ldx8(kp2 + 32);
            f32x4 a = {0.f, 0.f, 0.f, 0.f}; a = mfma16(k0, qf[0], a); a = mfma16(k1, qf[1], a); S[kb][tt] = a; }
    }
    float mx = -1e30f;
    const int cs = min(max(qc - 8, 0), 48);
#pragma unroll
    for (int kb = 0; kb < NB; ++kb)
#pragma unroll
        for (int tt = 0; tt < 2; ++tt)
#pragma unroll
            for (int j = 0; j < 4; ++j) { float s = S[kb][tt][j] * 0.125f;
                if (LOCAL) { const int col = kc0 + 8 * g + 4 * tt + j; const int dc = min(max(col - qc + 15, 0), 30); const bool ok = col >= cs && col <= cs + 15;
                    const float bias = rpbs[(drow0 + kb) * 31 + dc]; s = ok ? s + bias : -1e30f; }
                S[kb][tt][j] = s; mx = fmaxf(mx, s); }
    mx = fmaxf(mx, __shfl_xor(mx, 16, 64)); mx = fmaxf(mx, __shfl_xor(mx, 32, 64));
    float l = 0.f;
#pragma unroll
    for (int kb = 0; kb < NB; ++kb)
#pragma unroll
        for (int tt = 0; tt < 2; ++tt)
#pragma unroll
            for (int j = 0; j < 4; ++j) { const float pv = __expf(S[kb][tt][j] - mx); S[kb][tt][j] = pv; l += pv; }
    l += __shfl_xor(l, 16, 64); l += __shfl_xor(l, 32, 64);
#pragma unroll
    for (int kb = 0; kb < NB; ++kb) {
        u32x4 pw; pw[0] = cvt_pk_bf16(S[kb][0][0], S[kb][0][1]); pw[1] = cvt_pk_bf16(S[kb][0][2], S[kb][0][3]); pw[2] = cvt_pk_bf16(S[kb][1][0], S[kb][1][1]); pw[3] = cvt_pk_bf16(S[kb][1][2], S[kb][1][3]);
        const bf16x8 pf = __builtin_bit_cast(bf16x8, pw);
#pragma unroll
        for (int dt = 0; dt < 4; ++dt) { const bf16x8 vf = ldx8(vtbase + (size_t)(16 * dt + lq) * vt_ld + kb * vblk_stride + 8 * g); O[dt] = mfma16(vf, pf, O[dt]); }
    }
    m_out = mx; l_out = l;
}

__device__ __forceinline__ void attn_store_row(const bf16_t* P, bf16_t* CC, size_t orow, int h, int g, const f32x4 (&O)[4], float scale) {
    const int d0 = h * 64 + 16 * g;
#pragma unroll
    for (int hf = 0; hf < 2; ++hf) { float z[8], r[8]; unpack8(*(const u32x4*)(P + orow * PS + PC_ZA + d0 + 8 * hf), z);
#pragma unroll
        for (int k = 0; k < 8; ++k) r[k] = O[k & 3][2 * hf + (k >> 2)] * scale * silu_f(z[k]);
        *(u32x4*)(CC + orow * D + d0 + 8 * hf) = pack8(r); }
}
__device__ __forceinline__ void attn_merge_store(const Params& p, float* mrg, int wid, int lane, int h, size_t orow, float m, float l, f32x4 (&O)[4]) {
    const int cb = wid & 3, lq = lane & 15, g = lane >> 4;
    if (wid >= 4) {
#pragma unroll
        for (int dt = 0; dt < 4; ++dt)
#pragma unroll
            for (int j = 0; j < 4; ++j) mrg[(cb * 18 + dt * 4 + j) * 64 + lane] = O[dt][j];
        mrg[(cb * 18 + 16) * 64 + lane] = m; mrg[(cb * 18 + 17) * 64 + lane] = l;
    }
    __syncthreads();
    if (wid < 4) {
        const float m2 = mrg[(cb * 18 + 16) * 64 + lane], l2 = mrg[(cb * 18 + 17) * 64 + lane];
        const float mm = fmaxf(m, m2), a1 = __expf(m - mm), a2 = __expf(m2 - mm), inv = 1.f / (a1 * l + a2 * l2);
        const bf16_t* P = (const bf16_t*)(p.ws + WS_P); bf16_t* CC = (bf16_t*)(p.ws + WS_ACT);
#pragma unroll
        for (int dt = 0; dt < 4; ++dt)
#pragma unroll
            for (int j = 0; j < 4; ++j) { const float o2 = mrg[(cb * 18 + dt * 4 + j) * 64 + lane]; O[dt][j] = a1 * O[dt][j] + a2 * o2; }
        attn_store_row(P, CC, orow, h, g, O, inv);
    }
    __syncthreads();
}

constexpr int CK_LD = 72, CV_LD = 264;
constexpr float LOG2E = 1.4426950408889634f;
__device__ __forceinline__ void na_pv(const f32x4 s0, const f32x4 s1, const bf16x8 (&vf)[4], float& l, f32x4 (&O)[4]) {
    float p[8];
#pragma unroll
    for (int j = 0; j < 4; ++j) { p[j] = __builtin_amdgcn_exp2f(s0[j]); p[4 + j] = __builtin_amdgcn_exp2f(s1[j]); }
    l += ((p[0] + p[1]) + (p[2] + p[3])) + ((p[4] + p[5]) + (p[6] + p[7]));
    u32x4 pw; pw[0] = cvt_pk_bf16(p[0], p[1]); pw[1] = cvt_pk_bf16(p[2], p[3]); pw[2] = cvt_pk_bf16(p[4], p[5]); pw[3] = cvt_pk_bf16(p[6], p[7]);
    const bf16x8 pf = __builtin_bit_cast(bf16x8, pw);
#pragma unroll
    for (int dt = 0; dt < 4; ++dt) O[dt] = mfma16(vf[dt], pf, O[dt]);
}
static __device__ void na_pair(const Params& p, unsigned char* shm, int l, int pi) {
    const int quarter = pi & 3, bh = pi >> 2, h = bh & 15, b = bh >> 4;
    float* rpbs = (float*)shm + 16;
    bf16_t* cK = (bf16_t*)(shm + 2176);
    bf16_t* cV = cK + 256 * CK_LD;
    const int tid = tid_fresh(), wid = __builtin_amdgcn_readfirstlane(tid >> 6), lane = tid & 63, lq = lane & 15, g = lane >> 4;
    const bf16_t* P = (const bf16_t*)(p.ws + WS_P);
    for (int e = tid - 16; e < 528; e += 512) rpbs[e] = e < 0 ? 0.f : (e < 465 ? p.rpb[(size_t)(l * 16 + h) * 465 + e] * LOG2E : -1e30f);
    for (int e = tid; e < 256 * 8; e += 512) { const int k = e >> 3, sg = e & 7;
        *(u32x4*)(cK + k * CK_LD + sg * 8) = *(const u32x4*)(P + ((size_t)NLAT + b * 256 + k) * PS + PC_KA + h * 64 + sg * 8); }
    { const bf16_t* vt = (const bf16_t*)(p.ws + WS_VTC) + (size_t)((b * 16 + h) * 64) * 256;
      for (int e = tid; e < 64 * 32; e += 512) { const int d = e >> 5, sg = e & 31; *(u32x4*)(cV + d * CV_LD + sg * 8) = *(const u32x4*)(vt + d * 256 + sg * 8); } }
    __syncthreads();
    const LAS bf16_t* cKl = (const LAS bf16_t*)cK; const LAS bf16_t* cVl = (const LAS bf16_t*)cV;
    const int krow = 8 * (lq >> 2) + (lq & 3);
    constexpr float SC2 = 0.125f * LOG2E;
#pragma unroll 1
    for (int wi = wid; wi < 32; wi += 8) {
        const int rA = quarter * 16 + 2 * (wi >> 2), rB = rA + 1, cb = wi & 3;
        const int RA = min(max(rA - 4, 0), 56), RB = min(max(rB - 4, 0), 56), dd = RB - RA;
        const int qc = 16 * cb + lq, cs = min(max(qc - 8, 0), 48);
        const int kc0 = cb == 0 ? 0 : (cb == 1 ? 8 : (cb == 2 ? 24 : 32));
        const size_t rowA = (size_t)b * 4096 + rA * 64 + qc, rowB = rowA + 64;
        bf16x8 qA[2], qB[2];
        { const bf16_t* qp = P + rowA * PS + PC_QA + h * 64 + 8 * g; qA[0] = *(const bf16x8*)qp; qA[1] = *(const bf16x8*)(qp + 32);
          qp += (size_t)64 * PS; qB[0] = *(const bf16x8*)qp; qB[1] = *(const bf16x8*)(qp + 32); }
        float mk[2][4]; const int bbase = kc0 + 8 * g - qc + 15;
#pragma unroll
        for (int tt = 0; tt < 2; ++tt)
#pragma unroll
            for (int j = 0; j < 4; ++j) { const int col = kc0 + 8 * g + 4 * tt + j; mk[tt][j] = (col >= cs && col <= cs + 15) ? 80.f : -1e30f; }
        f32x4 OA[4], OB[4];
#pragma unroll
        for (int dt = 0; dt < 4; ++dt) { OA[dt] = (f32x4){0.f, 0.f, 0.f, 0.f}; OB[dt] = (f32x4){0.f, 0.f, 0.f, 0.f}; }
        float lA = 0.f, lB = 0.f;
        const bf16_t* kb0 = (const bf16_t*)(p.ws + WS_KT) + (size_t)(b * 16 + h) * 262144 + (size_t)(RA * 16 + (kc0 >> 2)) * 256 + (lq >> 2) * 512 + (lq & 3) * 32 + 8 * g;
        const bf16_t* vb0 = (const bf16_t*)(p.ws + WS_VT) + (size_t)(b * 16 + h) * 262144 + (size_t)(RA * 8 + (kc0 >> 3)) * 512 + (g * 64 + lq) * 8;
        {
            const int nrows = 8 + dd;
            bf16x8 kS[2][2][2], vS[2][4];
#define NA_LDL(SL, U) do { const bf16_t* kp_ = kb0 + (size_t)(U) * 4096; \
                kS[SL][0][0] = *(const bf16x8*)kp_; kS[SL][0][1] = *(const bf16x8*)(kp_ + 128); kS[SL][1][0] = *(const bf16x8*)(kp_ + 256); kS[SL][1][1] = *(const bf16x8*)(kp_ + 384); \
                _Pragma("unroll") for (int dt_ = 0; dt_ < 4; ++dt_) vS[SL][dt_] = *(const bf16x8*)(vb0 + (size_t)(U) * 4096 + dt_ * 128); } while (0)
#define NA_ROW(SL, U) do { const int u_ = (U); const bool actA = u_ < 8, actB = u_ >= dd; \
                const int drA = actA ? min(max(RA + u_ - rA + 7, 0), 14) * 31 : 465, drB = actB ? min(max(RA + u_ - rB + 7, 0), 14) * 31 : 465; \
                f32x4 sa[2], sb[2]; \
                _Pragma("unroll") for (int tt = 0; tt < 2; ++tt) { f32x4 a = {0.f, 0.f, 0.f, 0.f}; a = mfma16(kS[SL][tt][0], qA[0], a); a = mfma16(kS[SL][tt][1], qA[1], a); \
                    f32x4 c = {0.f, 0.f, 0.f, 0.f}; c = mfma16(kS[SL][tt][0], qB[0], c); c = mfma16(kS[SL][tt][1], qB[1], c); \
                    _Pragma("unroll") for (int j = 0; j < 4; ++j) { const float ba = rpbs[drA + bbase + 4 * tt + j], bb = rpbs[drB + bbase + 4 * tt + j]; \
                        a[j] = fminf(a[j] * SC2 + ba, mk[tt][j]); c[j] = fminf(c[j] * SC2 + bb, mk[tt][j]); } \
                    sa[tt] = a; sb[tt] = c; } \
                na_pv(sa[0], sa[1], vS[SL], lA, OA); na_pv(sb[0], sb[1], vS[SL], lB, OB); } while (0)
            NA_LDL(0, 0);
#pragma unroll 1
            for (int u = 0; u < 8; u += 2) {
                NA_LDL(1, u + 1);
                NA_ROW(0, u);
                if (u + 2 < nrows) NA_LDL(0, u + 2);
                NA_ROW(1, u + 1);
            }
            if (dd) NA_ROW(0, 8);
#undef NA_ROW
#undef NA_LDL
        }
        {
            bf16x8 kS[2][2][2], vS[2][4];
#define NA_LDC(SL, KB) do { const LAS bf16_t* kp_ = cKl + ((KB) * 32 + krow) * CK_LD + 8 * g; \
                kS[SL][0][0] = *(const LAS bf16x8*)kp_; kS[SL][0][1] = *(const LAS bf16x8*)(kp_ + 32); kS[SL][1][0] = *(const LAS bf16x8*)(kp_ + 4 * CK_LD); kS[SL][1][1] = *(const LAS bf16x8*)(kp_ + 4 * CK_LD + 32); \
                _Pragma("unroll") for (int dt_ = 0; dt_ < 4; ++dt_) vS[SL][dt_] = *(const LAS bf16x8*)(cVl + (16 * dt_ + lq) * CV_LD + (KB) * 32 + 8 * g); } while (0)
#define NA_CTX(SL) do { f32x4 sa[2], sb[2]; \
                _Pragma("unroll") for (int tt = 0; tt < 2; ++tt) { f32x4 a = {0.f, 0.f, 0.f, 0.f}; a = mfma16(kS[SL][tt][0], qA[0], a); a = mfma16(kS[SL][tt][1], qA[1], a); \
                    f32x4 c = {0.f, 0.f, 0.f, 0.f}; c = mfma16(kS[SL][tt][0], qB[0], c); c = mfma16(kS[SL][tt][1], qB[1], c); \
                    _Pragma("unroll") for (int j = 0; j < 4; ++j) { a[j] = fminf(a[j] * SC2, 80.f); c[j] = fminf(c[j] * SC2, 80.f); } \
                    sa[tt] = a; sb[tt] = c; } \
                na_pv(sa[0], sa[1], vS[SL], lA, OA); na_pv(sb[0], sb[1], vS[SL], lB, OB); } while (0)
            NA_LDC(0, 0);
#pragma unroll 1
            for (int kb = 0; kb < 8; kb += 2) {
                NA_LDC(1, kb + 1);
                NA_CTX(0);
                if (kb + 2 < 8) NA_LDC(0, kb + 2);
                NA_CTX(1);
            }
#undef NA_CTX
#undef NA_LDC
        }
        lA += __shfl_xor(lA, 16, 64); lA += __shfl_xor(lA, 32, 64); lB += __shfl_xor(lB, 16, 64); lB += __shfl_xor(lB, 32, 64);
        const float iA = 1.f / lA, iB = 1.f / lB;
        bf16_t* CC = (bf16_t*)(p.ws + WS_ACT);
        attn_store_row(P, CC, rowA, h, g, OA, iA);
        attn_store_row(P, CC, rowB, h, g, OB, iB);
    }
    __syncthreads();
}

static __device__ void ctxattn_item(const Params& p, unsigned char* shm, int item) {
    const int qb = item & 3, h = (item >> 2) & 15, b = item >> 6;
    float* mrg = (float*)shm + 512;
    const int tid = tid_fresh(), wid = tid >> 6, lane = tid & 63, lq = lane & 15, g = lane >> 4, cb = wid & 3;
    const bf16_t* P = (const bf16_t*)(p.ws + WS_P);
    const size_t orow = (size_t)NLAT + b * 256 + qb * 64 + 16 * cb + lq;
    const bf16_t* qrow = P + orow * PS + PC_QA + h * 64;
    f32x4 O[4];
#pragma unroll
    for (int dt = 0; dt < 4; ++dt) O[dt] = (f32x4){0.f, 0.f, 0.f, 0.f};
    float m, lsum;
    const int koff = wid < 4 ? 0 : 128;
    const bf16_t* kbase = P + ((size_t)NLAT + b * 256 + koff) * PS + PC_KA + h * 64;
    const bf16_t* vtbase = (const bf16_t*)(p.ws + WS_VTC) + (size_t)((b * 16 + h) * 64) * 256 + koff;
    attn_part<4, false, PS>(qrow, kbase, (size_t)32 * PS, vtbase, 256, 32, (const float*)shm, 0, 0, 0, lq, g, m, lsum, O);
    attn_merge_store(p, mrg, wid, lane, h, orow, m, lsum, O);
}

static __device__ void conv_item(const Params& p, unsigned char* shm, int l, int item) {
    int b, t0, Lseq; size_t rowbase;
    if (item < 512) { b = item >> 7; t0 = (item & 127) * 32; Lseq = SEQ; rowbase = (size_t)b * 4096; }
    else { const int j = item - 512; b = j >> 3; t0 = (j & 7) * 32; Lseq = LC; rowbase = (size_t)NLAT + b * 256; }
    float* u = (float*)shm;
    const bf16_t* P = (const bf16_t*)(p.ws + WS_P); bf16_t* CC = (bf16_t*)(p.ws + WS_ACT);
    const int tid = tid_fresh(), wid = tid >> 6, lane = tid & 63;
    u32x4 ra[8], rg[8];
#pragma unroll
    for (int it = 0; it < 8; ++it) { const int e = tid + it * 512, tt = e >> 6, c8 = (e & 63) * 8, t = t0 - 15 + tt;
        ra[it] = (u32x4){0u, 0u, 0u, 0u}; rg[it] = (u32x4){0u, 0u, 0u, 0u};
        if (tt < 62 && t >= 0 && t < Lseq) { const bf16_t* rp = P + (rowbase + t) * PS; ra[it] = *(const u32x4*)(rp + PC_CA + c8); rg[it] = *(const u32x4*)(rp + PC_CG + c8); } }
    float w[31];
#pragma unroll
    for (int j = 0; j < 31; ++j) w[j] = p.conv_w[(size_t)(l * 31 + j) * 512 + tid];
    const float bias = p.conv_b[l * 512 + tid];
#pragma unroll
    for (int it = 0; it < 8; ++it) { const int e = tid + it * 512, tt = e >> 6, c8 = (e & 63) * 8;
        if (tt < 62) { float a[8], gt[8], f[8]; unpack8(ra[it], a); unpack8(rg[it], gt);
#pragma unroll
            for (int k = 0; k < 8; ++k) f[k] = a[k] * sigm_f(gt[k]);
            *(f32x4*)(u + tt * 512 + c8) = (f32x4){f[0], f[1], f[2], f[3]}; *(f32x4*)(u + tt * 512 + c8 + 4) = (f32x4){f[4], f[5], f[6], f[7]}; } }
    __syncthreads();
    unsigned zc[4][4];
#pragma unroll
    for (int q = 0; q < 4; ++q)
#pragma unroll
        for (int k = 0; k < 4; ++k) zc[q][k] = *(const unsigned*)(P + (rowbase + t0 + wid * 4 + q) * PS + PC_ZC + 2 * (lane + 64 * k));
    {
        const int ch = tid; typedef float f2 __attribute__((ext_vector_type(2)));
        f2 wp[32], acc2[16];
#pragma unroll
        for (int m = 0; m < 32; ++m) wp[m] = (f2){m <= 30 ? w[m] : 0.f, m >= 1 ? w[m - 1] : 0.f};
#pragma unroll
        for (int k = 0; k < 16; ++k) acc2[k] = (f2){bias, bias};
#pragma unroll
        for (int tt = 0; tt < 62; ++tt) { const float val = u[tt * 512 + ch]; const f2 v2 = {val, val};
#pragma unroll
            for (int k = 0; k < 16; ++k) { const int m = tt - 2 * k; if (m >= 0 && m <= 31) acc2[k] = wp[m] * v2 + acc2[k]; } }
#pragma unroll
        for (int k = 0; k < 16; ++k) { u[(2 * k) * 512 + ch] = acc2[k][0]; u[(2 * k + 1) * 512 + ch] = acc2[k][1]; }
    }
    __syncthreads();
    float lg[8], lb[8];
#pragma unroll
    for (int k = 0; k < 4; ++k) { const int ch = 2 * (lane + 64 * k); lg[2 * k] = p.conv_ln_g[l * 512 + ch]; lg[2 * k + 1] = p.conv_ln_g[l * 512 + ch + 1]; lb[2 * k] = p.conv_ln_b[l * 512 + ch]; lb[2 * k + 1] = p.conv_ln_b[l * 512 + ch + 1]; }
#pragma unroll
    for (int q = 0; q < 4; ++q) { const int t = wid * 4 + q; float v[8], s = 0.f;
#pragma unroll
        for (int k = 0; k < 4; ++k) { v[2 * k] = u[t * 512 + 2 * (lane + 64 * k)]; v[2 * k + 1] = u[t * 512 + 2 * (lane + 64 * k) + 1]; s += v[2 * k] + v[2 * k + 1]; }
        const float mu = wsum(s) * (1.f / 512.f); float qq = 0.f;
#pragma unroll
        for (int i = 0; i < 8; ++i) { v[i] -= mu; qq += v[i] * v[i]; }
        const float rstd = rsqrtf(wsum(qq) * (1.f / 512.f) + 1e-5f);
        const size_t row = rowbase + t0 + t;
#pragma unroll
        for (int k = 0; k < 4; ++k) { const float y0 = v[2 * k] * rstd * lg[2 * k] + lb[2 * k], y1 = v[2 * k + 1] * rstd * lg[2 * k + 1] + lb[2 * k + 1];
            *(unsigned*)(CC + row * D + 1536 + 2 * (lane + 64 * k)) = cvt_pk_bf16(silu_f(y0) * silu_f(bflo(zc[q][k])), silu_f(y1) * silu_f(bfhi(zc[q][k]))); } }
    __syncthreads();
}

__device__ __forceinline__ f32x4 mma_lds(const bf16_t* A, int lda, const bf16_t* B, int ldb, int K, int lq, int g, f32x4 acc) {
    for (int k0 = 0; k0 < K; k0 += 32) { const bf16x8 a = *(const bf16x8*)(A + lq * lda + k0 + 8 * g), b = *(const bf16x8*)(B + lq * ldb + k0 + 8 * g); acc = mfma16(a, b, acc); }
    return acc;
}
__device__ __forceinline__ size_t gla_row0(int b, int ci) { return ci < 4 ? (size_t)NLAT + b * 256 + ci * 64 : (size_t)b * 4096 + (ci - 4) * 64; }
__device__ __forceinline__ void gla_load_rope(const Params& p, int tid, float* dst, size_t row0, int colbase, int ci, float scale) {
    const int c = tid >> 3, seg = tid & 7;
    const bf16_t* rp = (const bf16_t*)(p.ws + WS_P) + (row0 + c) * PS + colbase;
    float own[8]; unpack8(*(const u32x4*)(rp + seg * 8), own);
    if (ci >= 4) { float oth[8]; unpack8(*(const u32x4*)(rp + (seg ^ 2) * 8), oth);
        const float* rope = (const float*)(p.ws + WS_ROPE); const int pos = seg < 4 ? ci - 4 : c; const int i0 = (seg & 1) * 8;
        const f32x4 c0 = *(const f32x4*)(rope + pos * 16 + i0), c1 = *(const f32x4*)(rope + pos * 16 + i0 + 4), s0 = *(const f32x4*)(rope + 1024 + pos * 16 + i0), s1 = *(const f32x4*)(rope + 1024 + pos * 16 + i0 + 4);
        const float csv[8] = {c0[0], c0[1], c0[2], c0[3], c1[0], c1[1], c1[2], c1[3]}, snv[8] = {s0[0], s0[1], s0[2], s0[3], s1[0], s1[1], s1[2], s1[3]};
#pragma unroll
        for (int e = 0; e < 8; ++e) { const float cs = csv[e], sn = snv[e];
            own[e] = (seg & 2) ? oth[e] * sn + own[e] * cs : own[e] * cs - oth[e] * sn; } }
    *(f32x4*)(dst + c * 64 + seg * 8) = (f32x4){own[0] * scale, own[1] * scale, own[2] * scale, own[3] * scale};
    *(f32x4*)(dst + c * 64 + seg * 8 + 4) = (f32x4){own[4] * scale, own[5] * scale, own[6] * scale, own[7] * scale};
}
__device__ __forceinline__ void gla_load_vT(const Params& p, int tid, bf16_t* VTs, size_t row0, int h) {
    for (int e = tid; e < 1024; e += 512) { const int c = e >> 4, seg = e & 15;
        const u32x4 w = *(const u32x4*)((const bf16_t*)(p.ws + WS_P) + (row0 + c) * PS + PC_VB + h * 128 + seg * 8);
#pragma unroll
        for (int k = 0; k < 4; ++k) { VTs[(seg * 8 + 2 * k) * 72 + c] = (bf16_t)(w[k] & 0xffffu); VTs[(seg * 8 + 2 * k + 1) * 72 + c] = (bf16_t)(w[k] >> 16); } }
}
__device__ __forceinline__ void gla_stage_gate(const Params& p, int tid, float* w2s, bf16_t* lrs, int l, int h, size_t row0) {
    { const int row = tid >> 4, ch = (tid & 15) * 4; *(f32x4*)(w2s + row * 64 + ch) = *(const f32x4*)(p.gla_w2 + (size_t)(l * 32 + row) * 256 + h * 64 + ch); }
    if (tid < 256) { const int tok = tid >> 2, ch = (tid & 3) * 8; *(u32x4*)(lrs + tok * 32 + ch) = *(const u32x4*)((const bf16_t*)(p.ws + WS_P) + (row0 + tok) * PS + PC_GLR + ch); }
}
__device__ __forceinline__ float gla_g8(const Params& p, int tid, const float* w2s, const bf16_t* lrs, int l, int h, int dir, float (&bl)[8]) {
    const int dk = tid & 63, cgp = tid >> 6;
    float w2r[16];
#pragma unroll
    for (int r = 0; r < 16; ++r) w2r[r] = w2s[(dir * 16 + r) * 64 + dk];
    const float bias = p.gla_b[(l * 2 + dir) * 256 + h * 64 + dk];
    float gv[8];
#pragma unroll
    for (int cc = 0; cc < 8; ++cc) { const bf16_t* lp = lrs + (cgp * 8 + cc) * 32 + dir * 16;
        float t0[8], t1[8]; unpack8(*(const u32x4*)lp, t0); unpack8(*(const u32x4*)(lp + 8), t1);
        float x = bias;
#pragma unroll
        for (int r = 0; r < 8; ++r) x += t0[r] * w2r[r] + t1[r] * w2r[8 + r];
        gv[cc] = (fminf(x, 0.f) - __logf(1.f + __expf(-fabsf(x)))) * (1.f / 16.f); }
    float tot = 0.f;
    if (dir == 0) {
#pragma unroll
        for (int cc = 0; cc < 8; ++cc) { tot += gv[cc]; bl[cc] = tot; }
    } else {
#pragma unroll
        for (int cc = 7; cc >= 0; --cc) { tot += gv[cc]; bl[cc] = tot; }
    }
    return tot;
}

static __device__ void gla_g1_item(const Params& p, unsigned char* shm, int l, int item) {
    const int ci = item % NCHUNK, bh = item / NCHUNK, h = bh & 3, b = bh >> 2;
    float* kf = (float*)shm;
    float* part = kf + 4096;
    bf16_t* VTs = (bf16_t*)(part + 1024);
    bf16_t* KdT = VTs + 128 * 72;
    const int tid = tid_fresh(), wid = tid >> 6, lane = tid & 63, lq = lane & 15, g = lane >> 4, dk = tid & 63, cgp = tid >> 6;
    const size_t row0 = gla_row0(b, ci);
    float* w2s = (float*)(KdT + 2 * 64 * 72);
    bf16_t* lrs = (bf16_t*)(w2s + 2048);
    gla_load_rope(p, tid, kf, row0, PC_KB + h * 64, ci, 1.f);
    gla_load_vT(p, tid, VTs, row0, h);
    gla_stage_gate(p, tid, w2s, lrs, l, h, row0);
    __syncthreads();
    float bl[2][8];
#pragma unroll
    for (int dir = 0; dir < 2; ++dir) part[(dir * 8 + cgp) * 64 + dk] = gla_g8(p, tid, w2s, lrs, l, h, dir, bl[dir]);
    __syncthreads();
#pragma unroll
    for (int dir = 0; dir < 2; ++dir) {
        float off = 0.f, btot = 0.f;
#pragma unroll
        for (int q = 0; q < 8; ++q) { const float pv = part[(dir * 8 + q) * 64 + dk]; btot += pv; if (dir == 0 ? q < cgp : q > cgp) off += pv; }
        const size_t sidx = (size_t)((dir * 4 + b) * 4 + h) * NCHUNK + ci;
        float f[8];
#pragma unroll
        for (int cc = 0; cc < 8; ++cc) { const float bv = bl[dir][cc] + off; f[cc] = kf[(cgp * 8 + cc) * 64 + dk] * __expf(btot - bv); }
        *(u32x4*)(KdT + (dir * 64 + dk) * 72 + cgp * 8) = pack8(f);
        if (cgp == 0) ((float*)(p.ws + WS_DEC))[sidx * 64 + dk] = __expf(btot);
    }
    __syncthreads();
#pragma unroll
    for (int dir = 0; dir < 2; ++dir) {
        const size_t sidx = (size_t)((dir * 4 + b) * 4 + h) * NCHUNK + ci;
        float* KV = (float*)(p.ws + WS_KVT) + sidx * 8192;
#pragma unroll
        for (int nt = 0; nt < 4; ++nt) { f32x4 acc = {0.f, 0.f, 0.f, 0.f}; acc = mma_lds(VTs + (16 * wid) * 72, 72, KdT + (dir * 64 + 16 * nt) * 72, 72, 64, lq, g, acc);
#pragma unroll
            for (int j = 0; j < 4; ++j) KV[(16 * wid + 4 * g + j) * 64 + 16 * nt + lq] = acc[j]; }
    }
    __syncthreads();
}

static __device__ void gla_scan_item(const Params& p, int item) {
    const int slab = item & 15, seq = item >> 4, dir = seq >> 4;
    const int e = slab * 512 + tid_fresh(), dk = e & 63;
    const float* KV = (const float*)(p.ws + WS_KVT) + (size_t)seq * NCHUNK * 8192 + e;
    bf16_t* KVS = (bf16_t*)(p.ws + WS_KVS) + (size_t)seq * NCHUNK * 8192 + e;
    const float* DEC = (const float*)(p.ws + WS_DEC) + (size_t)seq * NCHUNK * 64 + dk;
    float s = 0.f;
#pragma unroll 1
    for (int s0 = 0; s0 < NCHUNK; s0 += 17) { float kv[17], dc[17];
#pragma unroll
        for (int q = 0; q < 17; ++q) { const int st = s0 + q; const int ci = dir == 0 ? st : (st < 4 ? 3 - st : 71 - st); kv[q] = KV[(size_t)ci * 8192]; dc[q] = DEC[ci * 64]; }
#pragma unroll
        for (int q = 0; q < 17; ++q) { const int st = s0 + q; const int ci = dir == 0 ? st : (st < 4 ? 3 - st : 71 - st); KVS[(size_t)ci * 8192] = f2bf(s); s = dc[q] * s + kv[q]; } }
}

__device__ __forceinline__ void gla_cum(const Params& p, int tid, float* part, int l, int h, int dir, size_t row0, float (&bl)[8], float& btot) {
    const int dk = tid & 63, cgp = tid >> 6;
    float w2r[16];
#pragma unroll
    for (int r = 0; r < 16; ++r) w2r[r] = p.gla_w2[(size_t)((l * 2 + dir) * 16 + r) * 256 + h * 64 + dk];
    const float bias = p.gla_b[(l * 2 + dir) * 256 + h * 64 + dk];
    float gv[8];
#pragma unroll
    for (int cc = 0; cc < 8; ++cc) { const bf16_t* lp = (const bf16_t*)(p.ws + WS_P) + (row0 + cgp * 8 + cc) * PS + PC_GLR + dir * 16;
        float lr[16]; { float t8[8]; unpack8(*(const u32x4*)lp, t8);
#pragma unroll
            for (int e = 0; e < 8; ++e) lr[e] = t8[e];
            unpack8(*(const u32x4*)(lp + 8), t8);
#pragma unroll
            for (int e = 0; e < 8; ++e) lr[8 + e] = t8[e]; }
        float x = bias;
#pragma unroll
        for (int r = 0; r < 16; ++r) x += lr[r] * w2r[r];
        gv[cc] = (fminf(x, 0.f) - __logf(1.f + __expf(-fabsf(x)))) * (1.f / 16.f); }
    float tot = 0.f;
    if (dir == 0) {
#pragma unroll
        for (int cc = 0; cc < 8; ++cc) { tot += gv[cc]; bl[cc] = tot; }
    } else {
#pragma unroll
        for (int cc = 7; cc >= 0; --cc) { tot += gv[cc]; bl[cc] = tot; }
    }
    part[cgp * 64 + dk] = tot;
    __syncthreads();
    float off = 0.f; btot = 0.f;
#pragma unroll
    for (int q = 0; q < 8; ++q) { const float pv = part[q * 64 + dk]; btot += pv; if (dir == 0 ? q < cgp : q > cgp) off += pv; }
#pragma unroll
    for (int cc = 0; cc < 8; ++cc) bl[cc] += off;
}

static __device__ void gla_g3_item(const Params& p, unsigned char* shm, int l, int b, int h, int ci) {
    float* qf = (float*)shm;
    float* kf = qf + 4096;
    float* part = kf + 4096;
    bf16_t* VTs = (bf16_t*)(part + 1024);
    bf16_t* STs = VTs + 128 * 72;
    bf16_t* qt = STs + 2 * 128 * 72;
    bf16_t* kt = qt + 64 * 72;
    bf16_t* att = kt + 64 * 72;
    float* osh = qf;
    const int tid = tid_fresh(), wid = tid >> 6, lane = tid & 63, lq = lane & 15, g = lane >> 4, dk = tid & 63, cgp = tid >> 6;
    const size_t row0 = gla_row0(b, ci);
    gla_load_rope(p, tid, qf, row0, PC_QB + h * 64, ci, 0.125f);
    gla_load_rope(p, tid, kf, row0, PC_KB + h * 64, ci, 1.f);
    gla_load_vT(p, tid, VTs, row0, h);
    float* w2s = (float*)(att + 64 * 72);
    bf16_t* lrs = (bf16_t*)(w2s + 2048);
    gla_stage_gate(p, tid, w2s, lrs, l, h, row0);
#pragma unroll
    for (int dir = 0; dir < 2; ++dir) { const bf16_t* KVS = (const bf16_t*)(p.ws + WS_KVS) + ((size_t)((dir * 4 + b) * 4 + h) * NCHUNK + ci) * 8192;
#pragma unroll
        for (int q = 0; q < 2; ++q) { const int e8 = (q * 512 + tid) * 8; *(u32x4*)(STs + (dir * 128 + (e8 >> 6)) * 72 + (e8 & 63)) = *(const u32x4*)(KVS + e8); } }
    f32x4 oacc[4];
#pragma unroll
    for (int it = 0; it < 4; ++it) oacc[it] = (f32x4){0.f, 0.f, 0.f, 0.f};
    __syncthreads();
    float blv[2][8];
#pragma unroll
    for (int dir = 0; dir < 2; ++dir) part[(dir * 8 + cgp) * 64 + dk] = gla_g8(p, tid, w2s, lrs, l, h, dir, blv[dir]);
    __syncthreads();
#pragma unroll
    for (int dir = 0; dir < 2; ++dir) {
        float off = 0.f;
#pragma unroll
        for (int q = 0; q < 8; ++q) { const float pv = part[(dir * 8 + q) * 64 + dk]; if (dir == 0 ? q < cgp : q > cgp) off += pv; }
#pragma unroll
        for (int cc = 0; cc < 8; ++cc) { const int c = cgp * 8 + cc; const float bv = blv[dir][cc] + off; qt[c * 72 + dk] = f2bf(qf[c * 64 + dk] * __expf(bv)); kt[c * 72 + dk] = f2bf(kf[c * 64 + dk] * __expf(-bv)); }
        __syncthreads();
        { const int it = wid >> 1;
#pragma unroll
          for (int q = 0; q < 2; ++q) { const int jt = 2 * (wid & 1) + q; f32x4 a = {0.f, 0.f, 0.f, 0.f}; a = mma_lds(qt + (16 * it) * 72, 72, kt + (16 * jt) * 72, 72, 64, lq, g, a);
#pragma unroll
              for (int j = 0; j < 4; ++j) { const int i = 16 * it + 4 * g + j, jj = 16 * jt + lq; const bool keep = dir == 0 ? jj <= i : jj >= i; att[i * 72 + jj] = f2bf(keep ? a[j] : 0.f); } } }
        __syncthreads();
#pragma unroll
        for (int it = 0; it < 4; ++it) { oacc[it] = mma_lds(qt + (16 * it) * 72, 72, STs + (dir * 128 + 16 * wid) * 72, 72, 64, lq, g, oacc[it]);
            oacc[it] = mma_lds(att + (16 * it) * 72, 72, VTs + (16 * wid) * 72, 72, 64, lq, g, oacc[it]); }
        __syncthreads();
    }
    const bf16_t* P = (const bf16_t*)(p.ws + WS_P); bf16_t* CC = (bf16_t*)(p.ws + WS_ACT);
    unsigned zz[8];
#pragma unroll
    for (int q = 0; q < 8; ++q) { const size_t row = row0 + wid * 8 + q; zz[q] = *(const unsigned*)(P + row * PS + PC_ZB + h * 128 + 2 * lane); }
    const float gn0 = p.gla_norm[l * 128 + 2 * lane], gn1 = p.gla_norm[l * 128 + 2 * lane + 1];
#pragma unroll
    for (int it = 0; it < 4; ++it)
#pragma unroll
        for (int j = 0; j < 4; ++j) osh[(16 * it + 4 * g + j) * 128 + 16 * wid + lq] = oacc[it][j];
    __syncthreads();
#pragma unroll
    for (int q = 0; q < 8; ++q) { const int c = wid * 8 + q; const float o0 = osh[c * 128 + 2 * lane], o1 = osh[c * 128 + 2 * lane + 1];
        const float ms = wsum(o0 * o0 + o1 * o1) * (1.f / 128.f); const float rr = rsqrtf(ms + 1e-6f);
        const size_t row = row0 + c;
        *(unsigned*)(CC + row * D + 1024 + h * 128 + 2 * lane) = cvt_pk_bf16(o0 * rr * gn0 * silu_f(bflo(zz[q])), o1 * rr * gn1 * silu_f(bfhi(zz[q]))); }
    __syncthreads();
}

#ifndef ONLY
#define EN(k) 1
#else
#define EN(k) (ONLY==(k))
#endif
template <int SUB> __device__ __forceinline__ void run_sub(const Params& p, unsigned char* shm, const int l) {
    const int G = gridDim.x, bid = blockIdx.x;
    if constexpr (SUB == 0) {
        pg8::Gemm gm{(const bf16_t*)(p.ws + WS_ACT), (const bf16_t*)(p.ws + WS_WINT) + (size_t)l * NINP * D, MROWS, NINP, D};
        pg8::StaticOrder S; S.init(gm.M, gm.N, G, bid);
        EpiIn E{(bf16_t*)(p.ws + WS_P), (bf16_t*)(p.ws + WS_VT), (bf16_t*)(p.ws + WS_VTC), (bf16_t*)(p.ws + WS_KT)};
        pg8::gemm_phase<EpiIn>((LAS unsigned char*)shm, gm, S, E);
    } else if constexpr (SUB == 1) {
        for (int pi = bid; pi < 256; pi += G) na_pair(p, shm, l, pi);
        const int n_ca = l == 0 ? 256 : 0, n_cv = l == 0 ? 544 : 512, n_g1 = 16 * NCHUNK;
        const int total = n_ca + n_cv + n_g1;
        for (int it = bid; it < total; it += G) {
            int i = it;
            if (i < n_ca) { ctxattn_item(p, shm, i); continue; } i -= n_ca;
            if (i < n_cv) { conv_item(p, shm, l, i); continue; } i -= n_cv;
            gla_g1_item(p, shm, l, i);
        }
    } else if constexpr (SUB == 2) {
        for (int it = bid; it < 512; it += G) gla_scan_item(p, it);
    } else if constexpr (SUB == 3) {
        const int nch = l == 0 ? NCHUNK : 64, total = 16 * nch;
        for (int it = bid; it < total; it += G) { const int bh = it / nch, cix = it % nch; gla_g3_item(p, shm, l, bh >> 2, bh & 3, l == 0 ? cix : cix + 4); }
    } else if constexpr (SUB == 4) {
        pg8::Gemm gm{(const bf16_t*)(p.ws + WS_ACT), (const bf16_t*)(p.ws + WS_WOUTT) + (size_t)l * D * D, l == 0 ? MROWS : NLAT, D, D};
        pg8::StaticOrder S; S.init(gm.M, gm.N, G, bid);
        EpiOutY E{(bf16_t*)(p.ws + WS_Y)};
        pg8::gemm_phase<EpiOutY>((LAS unsigned char*)shm, gm, S, E);
        if (l == 0) convert_layer1_filler(p, shm);
    } else {
        phase_ln(p, l == 0 ? 1 : 2);
    }
}
#define XB_TMO      128
#define XB_XCNT(j)  (256  + 64 * (j))
#define XB_XSUB(j)  (1280 + 64 * (j))
#define XB_XGEN(j)  (2304 + 64 * (j))
#define XB_TOP      3328
#define XB_TOPGEN   3392
#define XB_SPIN_CAP (1u << 18)
__device__ __forceinline__ unsigned xb_ld(unsigned* p)              { return __hip_atomic_load(p, __ATOMIC_RELAXED, __HIP_MEMORY_SCOPE_AGENT); }
__device__ __forceinline__ unsigned xb_add(unsigned* p, unsigned v) { return __hip_atomic_fetch_add(p, v, __ATOMIC_RELAXED, __HIP_MEMORY_SCOPE_AGENT); }
__device__ __forceinline__ unsigned xb_xcc_id() { return (unsigned)__builtin_amdgcn_s_getreg((3 << 11) | 20) & 0xFu; }
#define XB_SPIN(cond, bar) do { unsigned _sp = 0; while (cond) { __builtin_amdgcn_s_sleep(1); \
    if ((++_sp & 255u) == 0u) { if (xb_ld(&(bar)[XB_TMO])) break; if (_sp > XB_SPIN_CAP) { atomicAdd(&(bar)[XB_TMO], 1u); break; } } } } while (0)
__device__ __forceinline__ void xcd_barrier_complete(unsigned* bar, unsigned x, unsigned& nloc, unsigned& nx) {
    const unsigned G = gridDim.x * gridDim.y * gridDim.z;
    unsigned sum, cnt, mine, sp = 0u;
    for (;;) {
        sum = 0u; cnt = 0u; mine = 0u;
#pragma unroll
        for (unsigned j = 0; j < 16; ++j) { const unsigned c = xb_ld(&bar[XB_XCNT(j)]); sum += c; cnt += (c > 0u) ? 1u : 0u; mine = (j == x) ? c : mine; }
        if (sum == G) break;
        __builtin_amdgcn_s_sleep(1);
        if ((++sp & 255u) == 0u) { if (xb_ld(&bar[XB_TMO])) break; if (sp > XB_SPIN_CAP) { atomicAdd(&bar[XB_TMO], 1u); break; } }
    }
    nloc = mine > 0u ? mine : 1u; nx = cnt > 0u ? cnt : 1u;
}
__device__ __forceinline__ void xcd_barrier(unsigned* bar, volatile LAS unsigned* st) {
    asm volatile("s_waitcnt vmcnt(0)" ::: "memory");
    __syncthreads();
    if (threadIdx.x == 0) {
        const unsigned x = xb_xcc_id();
        __builtin_amdgcn_s_waitcnt(0);
        unsigned nloc = st[0], nx = st[1];
        if (nloc == 0u) { xcd_barrier_complete(bar, x, nloc, nx); st[0] = nloc; st[1] = nx; }
        const unsigned old = xb_add(&bar[XB_XSUB(x)], 1u);
        const unsigned gen = old / nloc;
        if (old + 1u == (gen + 1u) * nloc) {
            __builtin_amdgcn_fence(__ATOMIC_RELEASE, "agent");
            asm volatile("s_waitcnt vmcnt(0)" ::: "memory");
            const unsigned og = xb_add(&bar[XB_TOP], 1u);
            const unsigned tg = og / nx;
            if (og + 1u == (tg + 1u) * nx) xb_add(&bar[XB_TOPGEN], 1u);
            else XB_SPIN(xb_ld(&bar[XB_TOPGEN]) == tg, bar);
            __builtin_amdgcn_fence(__ATOMIC_ACQUIRE, "agent");
            xb_add(&bar[XB_XGEN(x)], 1u);
            asm volatile("s_waitcnt vmcnt(0)" ::: "memory");
        } else {
            XB_SPIN(xb_ld(&bar[XB_XGEN(x)]) == gen, bar);
            __builtin_amdgcn_fence(__ATOMIC_ACQUIRE, "agent");
            asm volatile("s_waitcnt vmcnt(0)" ::: "memory");
        }
    }
    __syncthreads();
}

__device__ __forceinline__ unsigned long long ld_u64(const unsigned* lp, int i) {
    const unsigned lo = (unsigned)__builtin_amdgcn_readfirstlane((int)lp[2 * i]), hi = (unsigned)__builtin_amdgcn_readfirstlane((int)lp[2 * i + 1]);
    return ((unsigned long long)hi << 32) | lo;
}
#define GPTR(T, i) ((T*)(__attribute__((address_space(1))) T*)ld_u64(lp, (i)))
__device__ __forceinline__ void load_params(Params& q, unsigned char* shm) {
    const unsigned* lp = (const unsigned*)(shm + LDS_BYTES - 256);
    asm volatile("" : "+v"(lp) :: "memory");
    q.x = GPTR(const float, 0); q.c = GPTR(const float, 1); q.ctx = GPTR(const float, 2); q.c_ctx = GPTR(const float, 3);
    q.w_ada = GPTR(const float, 4); q.b_ada = GPTR(const float, 5); q.w_in = GPTR(const float, 6); q.rpb = GPTR(const float, 7);
    q.gla_w2 = GPTR(const float, 8); q.gla_b = GPTR(const float, 9); q.gla_norm = GPTR(const float, 10); q.conv_w = GPTR(const float, 11);
    q.conv_b = GPTR(const float, 12); q.conv_ln_g = GPTR(const float, 13); q.conv_ln_b = GPTR(const float, 14); q.w_out = GPTR(const float, 15);
    q.post_ln_g = GPTR(const float, 16); q.post_ln_b = GPTR(const float, 17); q.out = GPTR(float, 18); q.ws = GPTR(unsigned char, 19);
    q.ph_lo = 0; q.ph_hi = 0;
}
__global__ void __launch_bounds__(512, 2) fwd_megakernel(Params p) {
    extern __shared__ __attribute__((aligned(16))) unsigned char shm[];
    cg::grid_group grid = cg::this_grid();
    if (threadIdx.x < sizeof(Params) / 4) ((unsigned*)(shm + LDS_BYTES - 256))[threadIdx.x] = ((const unsigned*)&p)[threadIdx.x];
    volatile LAS unsigned* xst = (volatile LAS unsigned*)((LAS unsigned char*)shm + LDS_BYTES - 64);
    if (threadIdx.x == 0) { xst[0] = 0u; xst[1] = 0u; }
    __syncthreads();
    if (threadIdx.x == 0) (void)xb_add(&((unsigned*)(p.ws + WS_BAR))[XB_XCNT(xb_xcc_id())], 1u);
    const int ph_lo = p.ph_lo, ph_hi = p.ph_hi;
#ifndef REPMASK
#define REPMASK 0
#endif
#define GSYNC_CG() do { asm volatile("" ::: "memory"); grid.sync(); asm volatile("" ::: "memory"); } while (0)
#define GSYNC_X() do { unsigned* bar_ = (unsigned*)(__attribute__((address_space(1))) unsigned*)(ld_u64((const unsigned*)(shm + LDS_BYTES - 256), 19) + WS_BAR); xcd_barrier(bar_, xst); } while (0)
#define SEAM_X() do { const unsigned* lp_ = (const unsigned*)(shm + LDS_BYTES - 256); asm volatile("" : "+v"(lp_) :: "memory"); unsigned* bar_ = (unsigned*)(__attribute__((address_space(1))) unsigned*)(ld_u64(lp_, 19) + WS_BAR); xcd_barrier(bar_, xst); } while (0)
    { Params q; load_params(q, shm); phase_prep(q, shm); }
    if (ph_lo != 0) GSYNC_CG();
    SEAM_X();
    { Params q; load_params(q, shm); phase_ln(q, 0); }
#pragma unroll 1
    for (int l = 0; l < 2; ++l) {
        SEAM_X(); { Params q; load_params(q, shm); run_sub<0>(q, shm, l); }
        SEAM_X(); { Params q; load_params(q, shm); run_sub<1>(q, shm, l); }
        SEAM_X(); { Params q; load_params(q, shm); run_sub<2>(q, shm, l); }
        SEAM_X(); { Params q; load_params(q, shm); run_sub<3>(q, shm, l); }
        SEAM_X(); { Params q; load_params(q, shm); run_sub<4>(q, shm, l); }
        SEAM_X(); { Params q; load_params(q, shm); run_sub<5>(q, shm, l); }
    }
}

extern "C" void kernel_launch(void* const* d_in, const int* in_sizes, int n_in, void* d_out, int out_size, void* d_ws, size_t ws_size, hipStream_t stream) {
    static int grid = 0;
    if (grid == 0) {
        if (n_in != 18 || ws_size < WS_TOTAL) { fprintf(stderr, "kernel_launch: unexpected n_in %d / ws_size %zu (need %zu)\n", n_in, ws_size, (size_t)WS_TOTAL); grid = -1; return; }
        int dev = 0, cus = 0, per_cu = 0;
        hipGetDevice(&dev); hipDeviceGetAttribute(&cus, hipDeviceAttributeMultiprocessorCount, dev);
        if (hipFuncSetAttribute((const void*)fwd_megakernel, hipFuncAttributeMaxDynamicSharedMemorySize, LDS_BYTES) != hipSuccess) { fprintf(stderr, "kernel_launch: hipFuncSetAttribute failed\n"); grid = -1; return; }
        if (hipOccupancyMaxActiveBlocksPerMultiprocessor(&per_cu, (const void*)fwd_megakernel, 512, LDS_BYTES) != hipSuccess || per_cu < 1) { fprintf(stderr, "kernel_launch: occupancy query says %d blocks/CU\n", per_cu); per_cu = 1; }
        (void)hipGetLastError();
        grid = cus * 1;
        if (grid > 256) grid = 256;
    }
    if (grid < 0) return;
    if (hipMemsetAsync((unsigned char*)d_ws + WS_BAR, 0, (size_t)XCD_BAR_WORDS * 4, stream) != hipSuccess) { fprintf(stderr, "kernel_launch: hipMemsetAsync of the barrier words failed\n"); return; }
    Params p{};
    const float** pp = (const float**)&p;
    for (int i = 0; i < 18; ++i) pp[i] = (const float*)d_in[i];
    p.out = (float*)d_out; p.ws = (unsigned char*)d_ws; p.ph_lo = 0; p.ph_hi = 14;
    void* args[] = {&p};
    hipError_t e = hipLaunchCooperativeKernel((const void*)fwd_megakernel, dim3(grid), dim3(512), args, LDS_BYTES, stream);
    if (e != hipSuccess) fprintf(stderr, "cooperative launch failed: %s (grid %d)\n", hipGetErrorString(e), grid);
}
```

```cpp
#include <hip/hip_runtime.h>
#include <hip/hip_cooperative_groups.h>
#include <cstdio>
namespace cg = cooperative_groups;

#define LAS __attribute__((address_space(3)))
typedef unsigned short bf16_t;
typedef short bf16x8 __attribute__((ext_vector_type(8)));
typedef float f32x4 __attribute__((ext_vector_type(4)));
typedef unsigned u32x4 __attribute__((ext_vector_type(4)));
typedef unsigned u32x2 __attribute__((ext_vector_type(2)));

constexpr int D = 2048, SEQ = 4096, LC = 256, NLAT = 16384, MROWS = 17408;
constexpr int NIN = 7200, NINP = 7424, PS = 6208;
constexpr int PC_QA = 0, PC_KA = 1024, PC_ZA = 2048, PC_QB = 3072, PC_KB = 3328, PC_VB = 3584, PC_ZB = 4096, PC_GLR = 4608, PC_CA = 4640, PC_CG = 5152, PC_ZC = 5664;
constexpr int NCHUNK = 68;
constexpr float ALPHA = 1.4142135623730951f;
constexpr size_t WS_WINT = 0;
constexpr size_t WS_WOUTT = WS_WINT + (size_t)2 * NINP * D * 2;
constexpr size_t WS_MOD = WS_WOUTT + (size_t)2 * D * D * 2;
constexpr size_t WS_ROPE = WS_MOD + (size_t)2 * 5 * 6144 * 4;
constexpr size_t WS_ACT = WS_ROPE + 8192;
constexpr size_t WS_P = WS_ACT + (size_t)MROWS * D * 2;
constexpr size_t WS_VT = WS_P + (size_t)MROWS * PS * 2;
constexpr size_t WS_VTC = WS_VT + (size_t)4 * 16 * 64 * 4096 * 2;
constexpr size_t WS_KVT = WS_VTC + (size_t)4 * 16 * 64 * 256 * 2;
constexpr size_t WS_DEC = WS_KVT + (size_t)2 * 16 * NCHUNK * 8192 * 4;
constexpr size_t WS_XC = WS_DEC + (size_t)2 * 16 * NCHUNK * 64 * 4;
constexpr size_t WS_KVS = WS_XC + (size_t)1024 * D * 4;
constexpr size_t WS_Y = WS_KVT;
constexpr size_t WS_KT = WS_KVS;
constexpr size_t WS_END = WS_KVS + (size_t)2 * 16 * NCHUNK * 8192 * 2;
constexpr size_t WS_BAR = (WS_END + 255) & ~(size_t)255;
constexpr int XCD_BAR_WORDS = 3456;
constexpr size_t WS_TOTAL = WS_BAR + (size_t)XCD_BAR_WORDS * 4;
constexpr int LDS_BYTES = 147456;

struct Params {
    const float *x, *c, *ctx, *c_ctx, *w_ada, *b_ada, *w_in, *rpb, *gla_w2, *gla_b, *gla_norm, *conv_w, *conv_b, *conv_ln_g, *conv_ln_b, *w_out, *post_ln_g, *post_ln_b;
    float* out; unsigned char* ws; int ph_lo, ph_hi;
};

typedef float f32x2_t __attribute__((ext_vector_type(2)));
typedef __bf16 bf16x2_t __attribute__((ext_vector_type(2)));
__device__ __forceinline__ unsigned cvt_pk_bf16(float lo, float hi) { const f32x2_t v = {lo, hi}; return __builtin_bit_cast(unsigned, __builtin_convertvector(v, bf16x2_t)); }
__device__ __forceinline__ bf16_t f2bf(float f) { return (bf16_t)(cvt_pk_bf16(f, 0.f) & 0xffffu); }
__device__ __forceinline__ float bf2f(bf16_t v) { return __uint_as_float(((unsigned)v) << 16); }
__device__ __forceinline__ float bflo(unsigned w) { return __uint_as_float(w << 16); }
__device__ __forceinline__ float bfhi(unsigned w) { return __uint_as_float(w & 0xffff0000u); }
__device__ __forceinline__ void unpack8(u32x4 w, float (&f)[8]) {
    f[0] = bflo(w[0]); f[1] = bfhi(w[0]); f[2] = bflo(w[1]); f[3] = bfhi(w[1]); f[4] = bflo(w[2]); f[5] = bfhi(w[2]); f[6] = bflo(w[3]); f[7] = bfhi(w[3]);
}
__device__ __forceinline__ u32x4 pack8(const float (&f)[8]) { u32x4 w; w[0] = cvt_pk_bf16(f[0], f[1]); w[1] = cvt_pk_bf16(f[2], f[3]); w[2] = cvt_pk_bf16(f[4], f[5]); w[3] = cvt_pk_bf16(f[6], f[7]); return w; }
__device__ __forceinline__ float silu_f(float x) { return x * __builtin_amdgcn_rcpf(1.f + __expf(-x)); }
__device__ __forceinline__ float sigm_f(float x) { return __builtin_amdgcn_rcpf(1.f + __expf(-x)); }
__device__ __forceinline__ float wsum(float v) {
#define WS_DPP(x, ctrl) __builtin_bit_cast(float, __builtin_amdgcn_update_dpp(0, __builtin_bit_cast(int, (x)), (ctrl), 0xF, 0xF, true))
    v += WS_DPP(v, 0xB1); v += WS_DPP(v, 0x4E); v += WS_DPP(v, 0x141); v += WS_DPP(v, 0x140);
#undef WS_DPP
    const int vi = __builtin_bit_cast(int, v);
    return (__builtin_bit_cast(float, __builtin_amdgcn_readlane(vi, 0)) + __builtin_bit_cast(float, __builtin_amdgcn_readlane(vi, 16)))
         + (__builtin_bit_cast(float, __builtin_amdgcn_readlane(vi, 32)) + __builtin_bit_cast(float, __builtin_amdgcn_readlane(vi, 48)));
}
__device__ __forceinline__ int tid_fresh() { int t = threadIdx.x; asm volatile("" : "+v"(t)); return t; }
__device__ __forceinline__ f32x4 mfma16(bf16x8 a, bf16x8 b, f32x4 c) { return __builtin_amdgcn_mfma_f32_16x16x32_bf16(a, b, c, 0, 0, 0); }

namespace pg8 {
constexpr int BM = 256, BK = 64, HALF = 128, HTB = HALF * BK * 2, STAGE_BYTES = 8 * HTB, NXCD = 8, WGM = 8;
__host__ __device__ __forceinline__ int lds_byte(int r, int c) { const int st = (r >> 4) * 2 + (c >> 5), rr = r & 15, cc = c & 31, ob = rr * 64 + cc * 2; return st * 1024 + (ob ^ (((ob >> 9) & 1) << 5)); }
__host__ __device__ __forceinline__ void stage_rc(int b, int& R, int& C) { const int st = b / 1024, sb = b % 1024, swz = sb ^ (((sb >> 9) & 1) << 5); R = (st >> 1) * 16 + swz / 64; C = (st & 1) * 32 + (swz % 64) / 2; }
__host__ __device__ __forceinline__ int perm32(int rho) { const int n = rho >> 4, i = rho & 15; return 8 * (i >> 2) + 4 * n + (i & 3); }
struct Unit { int pm, pn; };
struct Gemm { const bf16_t* A; const bf16_t* Bt; int M, N, K; };
struct StaticOrder {
    int nM, nN, nwg, G, c;
    __host__ __device__ void init(int M, int N, int G_, int c_) { nM = M / BM; nN = N / BM; nwg = nM * nN; G = G_; c = c_; }
    __host__ __device__ bool next(int i, Unit& u) const {
        const long L = (long)i * G + c; if (L >= nwg) return false;
        int wgid = (int)L; { const int q = nwg / NXCD, r = nwg % NXCD, xcd = wgid % NXCD, off = wgid / NXCD; wgid = (xcd < r ? xcd * (q + 1) : r * (q + 1) + (xcd - r) * q) + off; }
        const int nig = WGM * nN, gid = wgid / nig, fm = gid * WGM, gsz = (nM - fm) < WGM ? (nM - fm) : WGM;
        u.pm = fm + ((wgid % nig) % gsz); u.pn = (wgid % nig) / gsz; return true;
    }
};

template <class Epi>
__device__ __forceinline__ void gemm_phase(LAS unsigned char* lds, const Gemm g, const StaticOrder& S, const Epi& E) {
    const int tid = tid_fresh(), wid = __builtin_amdgcn_readfirstlane(tid >> 6), lane = tid & 63, wr = wid >> 2, wc = wid & 3, fr = lane & 15, fq = lane >> 4;
    const int K = g.K, nt = K / BK;
    unsigned voffA[2], voffB[2];
#pragma unroll
    for (int i = 0; i < 2; ++i) { int R, C; stage_rc(tid * 16 + i * 8192, R, C); const int Rb = Epi::PERM ? ((R & ~31) + perm32(R & 31)) : R;
        voffA[i] = (unsigned)(R * K + C) * 2u; voffB[i] = (unsigned)(Rb * K + C) * 2u; }
    const size_t kstep = (size_t)(BK * 2);
    const size_t hstep = (size_t)HALF * K * 2;
    const size_t tstep = 2 * hstep;
    const unsigned ldsw = (unsigned)wid * 1024u;
    const int aoff = lds_byte(wr * 64 + fr, fq * 8), boff = lds_byte(wc * 32 + fr, fq * 8);
#define PG8_SA(b, h) (((b) * 2 + (h)) * HTB)
#define PG8_SB(b, h) ((4 + (b) * 2 + (h)) * HTB)
#define PG8_STAGE(bufoff, gbase, voff) do { _Pragma("unroll") for (int _i = 0; _i < 2; ++_i) \
        __builtin_amdgcn_global_load_lds((const unsigned*)((const char*)(gbase) + (voff)[_i]), (LAS unsigned*)(lds + (bufoff) + ldsw + _i * 8192), 16, 0, 0); } while (0)
#define PG8_LDA(dst, b, h) do { _Pragma("unroll") for (int m = 0; m < 4; ++m) _Pragma("unroll") for (int k = 0; k < 2; ++k) dst[m][k] = *(const LAS bf16x8*)(lds + PG8_SA(b, h) + aoff + m * 2048 + k * 1024); } while (0)
#define PG8_LDB(dst, b, h) do { _Pragma("unroll") for (int n = 0; n < 2; ++n) _Pragma("unroll") for (int k = 0; k < 2; ++k) dst[n][k] = *(const LAS bf16x8*)(lds + PG8_SB(b, h) + boff + n * 2048 + k * 1024); } while (0)
#define PG8_MMA(ai, bj, At, Bt) do { __builtin_amdgcn_s_setprio(1); _Pragma("unroll") for (int m = 0; m < 4; ++m) _Pragma("unroll") for (int n = 0; n < 2; ++n) _Pragma("unroll") for (int k = 0; k < 2; ++k) \
        acc[ai][bj][m][n] = __builtin_amdgcn_mfma_f32_16x16x32_bf16(Bt[n][k], At[m][k], acc[ai][bj][m][n], 0, 0, 0); __builtin_amdgcn_s_setprio(0); } while (0)
#define PG8_WAIT_V(n) asm volatile("s_waitcnt vmcnt(" #n ")" ::: "memory")
#define PG8_WAIT_L(n) asm volatile("s_waitcnt lgkmcnt(" #n ")" ::: "memory")
#define PG8_BAR __builtin_amdgcn_s_barrier()
#define PG8_SCHED __builtin_amdgcn_sched_barrier(0)
    Unit cur, nxt; int ui = 0;
    if (!S.next(0, cur)) return;
    f32x4 acc[2][2][4][2];
#pragma unroll
    for (int a = 0; a < 2; ++a)
#pragma unroll
        for (int b = 0; b < 2; ++b)
#pragma unroll
            for (int m = 0; m < 4; ++m)
#pragma unroll
                for (int n = 0; n < 2; ++n) acc[a][b][m][n] = (f32x4){0.f, 0.f, 0.f, 0.f};
    bf16x8 At[4][2], B0[2][2], B1[2][2];
    const char* cA = (const char*)g.A + (size_t)cur.pm * tstep; const char* cB = (const char*)g.Bt + (size_t)cur.pn * tstep;
    PG8_STAGE(PG8_SB(0, 0), cB, voffB); PG8_STAGE(PG8_SA(0, 0), cA, voffA); PG8_STAGE(PG8_SB(0, 1), cB + hstep, voffB); PG8_STAGE(PG8_SA(0, 1), cA + hstep, voffA);
    if (wr == 1) PG8_BAR;
    PG8_WAIT_V(4); PG8_BAR;
    PG8_STAGE(PG8_SB(1, 0), cB + kstep, voffB); PG8_STAGE(PG8_SA(1, 0), cA + kstep, voffA); PG8_STAGE(PG8_SB(1, 1), cB + hstep + kstep, voffB);
    PG8_WAIT_V(6); PG8_BAR;
    for (;;) {
        const bool has_next = S.next(ui + 1, nxt);
        const char* nA = has_next ? (const char*)g.A + (size_t)nxt.pm * tstep : cA; const char* nB = has_next ? (const char*)g.Bt + (size_t)nxt.pn * tstep : cB;
        for (int t = 0; t < nt; t += 2) {
            const bool last = (t == nt - 2);
            const char* a1 = cA + (size_t)(t + 1) * kstep;
            const char* a2 = last ? nA : cA + (size_t)(t + 2) * kstep; const char* b2 = last ? nB : cB + (size_t)(t + 2) * kstep;
            const char* a3 = a2 + kstep; const char* b3 = b2 + kstep;
            PG8_LDB(B0, 0, 0); PG8_SCHED; PG8_LDA(At, 0, 0); PG8_STAGE(PG8_SA(1, 1), a1 + hstep, voffA);
            PG8_WAIT_L(8); PG8_BAR; PG8_WAIT_L(0); PG8_MMA(0, 0, At, B0); PG8_BAR; PG8_SCHED;
            PG8_LDB(B1, 0, 1); PG8_STAGE(PG8_SB(0, 0), b2, voffB);
            PG8_BAR; PG8_WAIT_L(0); PG8_MMA(0, 1, At, B1); PG8_BAR;
            PG8_LDA(At, 0, 1); PG8_STAGE(PG8_SA(0, 0), a2, voffA);
            PG8_BAR; PG8_WAIT_L(0); PG8_MMA(1, 0, At, B0); PG8_BAR; PG8_SCHED;
            PG8_STAGE(PG8_SB(0, 1), b2 + hstep, voffB);
            PG8_WAIT_V(6); PG8_BAR; PG8_MMA(1, 1, At, B1); PG8_BAR;
            PG8_LDB(B0, 1, 0); PG8_SCHED; PG8_LDA(At, 1, 0); PG8_STAGE(PG8_SA(0, 1), a2 + hstep, voffA);
            PG8_WAIT_L(8); PG8_BAR; PG8_WAIT_L(0); PG8_MMA(0, 0, At, B0); PG8_BAR; PG8_SCHED;
            PG8_LDB(B1, 1, 1); PG8_STAGE(PG8_SB(1, 0), b3, voffB);
            PG8_BAR; PG8_WAIT_L(0); PG8_MMA(0, 1, At, B1); PG8_BAR;
            PG8_LDA(At, 1, 1); PG8_STAGE(PG8_SA(1, 0), a3, voffA);
            PG8_BAR; PG8_WAIT_L(0); PG8_MMA(1, 0, At, B0); PG8_BAR; PG8_SCHED;
            PG8_STAGE(PG8_SB(1, 1), b3 + hstep, voffB);
            PG8_WAIT_V(6); PG8_BAR; PG8_MMA(1, 1, At, B1); PG8_BAR;
        }
        E(acc, cur, wr, wc, fr, fq);
        if (!has_next) break;
#pragma unroll
        for (int a = 0; a < 2; ++a)
#pragma unroll
            for (int b = 0; b < 2; ++b)
#pragma unroll
                for (int m = 0; m < 4; ++m)
#pragma unroll
                    for (int n = 0; n < 2; ++n) acc[a][b][m][n] = (f32x4){0.f, 0.f, 0.f, 0.f};
        cur = nxt; cA = nA; cB = nB; ++ui;
    }
    PG8_WAIT_V(0);
    if (wr == 0) PG8_BAR;
    PG8_BAR;
#undef PG8_SA
#undef PG8_SB
#undef PG8_STAGE
#undef PG8_LDA
#undef PG8_LDB
#undef PG8_MMA
#undef PG8_WAIT_V
#undef PG8_WAIT_L
#undef PG8_BAR
#undef PG8_SCHED
}
}

struct EpiIn {
    static constexpr bool PERM = true;
    bf16_t* P; bf16_t* VT; bf16_t* VTC; bf16_t* KT;
    __device__ __forceinline__ void operator()(const f32x4 (&acc)[2][2][4][2], const pg8::Unit& u, int wr, int wc, int fr, int fq) const {
        const int row0 = u.pm * 256 + wr * 64 + fr;
        if (u.pn >= 8 && u.pn < 12) {
            const int c0 = (u.pn - 8) * 256 + wc * 32 + 8 * fq;
            if (u.pm < 64) {
                const int b = u.pm >> 4, t0 = row0 - b * 4096;
#pragma unroll
                for (int ai = 0; ai < 2; ++ai)
#pragma unroll
                    for (int m = 0; m < 4; ++m) { const int t = t0 + ai * 128 + m * 16;
#pragma unroll
                        for (int bj = 0; bj < 2; ++bj)
#pragma unroll
                            for (int n = 0; n < 2; ++n)
#pragma unroll
                                for (int j = 0; j < 4; ++j) { const int c = c0 + bj * 128 + 4 * n + j;
                                    VT[((((size_t)(b * 16 + (c >> 6)) * 512 + (t >> 3)) * 64 + (((c & 3) << 4) | ((c & 63) >> 2))) << 3) + (t & 7)] = f2bf(acc[ai][bj][m][n][j]); } }
            } else {
                const int b = u.pm - 64, t0 = row0 - NLAT - b * 256; bf16_t* base = VTC + (size_t)b * 1024 * 256;
#pragma unroll
                for (int ai = 0; ai < 2; ++ai)
#pragma unroll
                    for (int m = 0; m < 4; ++m) { const int t = t0 + ai * 128 + m * 16;
#pragma unroll
                        for (int bj = 0; bj < 2; ++bj)
#pragma unroll
                            for (int n = 0; n < 2; ++n)
#pragma unroll
                                for (int j = 0; j < 4; ++j) { const int c = c0 + bj * 128 + 4 * n + j; base[(size_t)((c & ~63) | ((c & 3) << 4) | ((c & 63) >> 2)) * 256 + t] = f2bf(acc[ai][bj][m][n][j]); } }
            }
        } else {
            const bool ktile = u.pn >= 4 && u.pn < 8 && u.pm < 64;
            const int cdst0 = u.pn * 256 - (u.pn >= 12 ? 1024 : 0) + wc * 32 + 8 * fq;
            const int ck0 = (u.pn - 4) * 256 + wc * 32 + 8 * fq, bb = u.pm >> 4;
#pragma unroll
            for (int ai = 0; ai < 2; ++ai)
#pragma unroll
                for (int m = 0; m < 4; ++m) { const int row = row0 + ai * 128 + m * 16; bf16_t* rowp = P + (size_t)row * PS + cdst0; const int t = row - bb * 4096;
#pragma unroll
                    for (int bj = 0; bj < 2; ++bj) if (u.pn < 28 || (bj == 0 && wc == 0)) {
                        const f32x4 v0 = acc[ai][bj][m][0], v1 = acc[ai][bj][m][1]; u32x4 w;
                        w[0] = cvt_pk_bf16(v0[0], v0[1]); w[1] = cvt_pk_bf16(v0[2], v0[3]); w[2] = cvt_pk_bf16(v1[0], v1[1]); w[3] = cvt_pk_bf16(v1[2], v1[3]);
                        bf16_t* dst = rowp + bj * 128;
                        if (ktile) { const int ck = ck0 + bj * 128, hh = ck >> 6, dim0 = ck & 63;
                            dst = KT + ((((((size_t)(bb * 16 + hh) * 1024 + (t >> 2)) * 2 + (dim0 >> 5)) * 4 + (t & 3)) << 5) + (dim0 & 31)); }
                        *(u32x4*)dst = w; } }
        }
    }
};
struct EpiOut {
    static constexpr bool PERM = false;
    const float* xlat; const float* xctx; float* olat; float* octx; const float* gate;
    __device__ __forceinline__ void operator()(const f32x4 (&acc)[2][2][4][2], const pg8::Unit& u, int wr, int wc, int fr, int fq) const {
        const int row0 = u.pm * 256 + wr * 64 + fr, col0 = u.pn * 256 + wc * 32 + 4 * fq;
#pragma unroll
        for (int ai = 0; ai < 2; ++ai)
#pragma unroll
            for (int m = 0; m < 4; ++m) { const int row = row0 + ai * 128 + m * 16; const float* xs; float* od; int mr;
                if (row < NLAT) { xs = xlat + (size_t)row * D; od = olat + (size_t)row * D; mr = row >> 12; } else { xs = xctx + (size_t)(row - NLAT) * D; od = octx + (size_t)(row - NLAT) * D; mr = 4; }
#pragma unroll
                for (int bj = 0; bj < 2; ++bj)
#pragma unroll
                    for (int n = 0; n < 2; ++n) { const int c = col0 + bj * 128 + n * 16;
                        const f32x4 xv = *(const f32x4*)(xs + c), gv = *(const f32x4*)(gate + mr * 6144 + c);
                        *(f32x4*)(od + c) = xv * ALPHA + gv * acc[ai][bj][m][n]; } }
    }
};

struct EpiOutY {
    static constexpr bool PERM = true;
    bf16_t* Y;
    __device__ __forceinline__ void operator()(const f32x4 (&acc)[2][2][4][2], const pg8::Unit& u, int wr, int wc, int fr, int fq) const {
        const int row0 = u.pm * 256 + wr * 64 + fr, c0 = u.pn * 256 + wc * 32 + 8 * fq;
#pragma unroll
        for (int ai = 0; ai < 2; ++ai)
#pragma unroll
            for (int m = 0; m < 4; ++m) { bf16_t* rowp = Y + (size_t)(row0 + ai * 128 + m * 16) * D + c0;
#pragma unroll
                for (int bj = 0; bj < 2; ++bj) { const f32x4 v0 = acc[ai][bj][m][0], v1 = acc[ai][bj][m][1]; u32x4 w;
                    w[0] = cvt_pk_bf16(v0[0], v0[1]); w[1] = cvt_pk_bf16(v0[2], v0[3]); w[2] = cvt_pk_bf16(v1[0], v1[1]); w[3] = cvt_pk_bf16(v1[2], v1[3]);
                    *(u32x4*)(rowp + bj * 128) = w; } }
    }
};

__device__ __forceinline__ void transpose_tile(const float* __restrict__ src, int N, bf16_t* __restrict__ dst, int kt, int nt, float* tile) {
    const int tid = tid_fresh(), k0 = kt * 64, n0 = nt * 256, wid = tid >> 6, nc = (tid & 63) * 4;
    f32x4 v[8];
#pragma unroll
    for (int i = 0; i < 8; ++i) { v[i] = (f32x4){0.f, 0.f, 0.f, 0.f}; if (n0 + nc < N) v[i] = *(const f32x4*)(src + (size_t)(k0 + wid + 8 * i) * N + n0 + nc); }
#pragma unroll
    for (int i = 0; i < 8; ++i) { float* tp = tile + (wid + 8 * i) * 257 + nc; tp[0] = v[i][0]; tp[1] = v[i][1]; tp[2] = v[i][2]; tp[3] = v[i][3]; }
    __syncthreads();
    { const int n = tid >> 1, ks = (tid & 1) * 32;
#pragma unroll
      for (int q = 0; q < 4; ++q) { float f[8];
#pragma unroll
          for (int e = 0; e < 8; ++e) f[e] = tile[(ks + q * 8 + e) * 257 + n];
          *(u32x4*)(dst + (size_t)(n0 + n) * D + k0 + ks + q * 8) = pack8(f); } }
    __syncthreads();
}

static __device__ void phase_prep(const Params& p, unsigned char* shm) {
    float* sl = (float*)shm; const int tid = tid_fresh();
    if (blockIdx.x == gridDim.x - 1) {
        float* rope = (float*)(p.ws + WS_ROPE);
        for (int e = tid; e < 1024; e += 512) { const int pos = e >> 4, i = e & 15; const float inv = exp2f(-(float)i * (13.287712379549449f / 16.f)); const float ang = (float)pos * inv;
            rope[e] = cosf(ang); rope[1024 + e] = sinf(ang); }
    }
    constexpr int NG = 192, TIN = 29 * 32, TOUT = 8 * 32, TOTAL = NG + (TIN + TOUT);
    for (int it = blockIdx.x; it < TOTAL; it += gridDim.x) {
        if (it < NG) {
            const int l = it / 96, n0 = (it % 96) * 64;
            for (int e = tid; e < 5 * 2048; e += 512) { const float v = e < 4 * 2048 ? p.c[e] : p.c_ctx[e - 4 * 2048]; sl[e] = silu_f(v); }
            __syncthreads();
            const int cq = tid & 15, ks = tid >> 4; float acc[5][4];
#pragma unroll
            for (int r = 0; r < 5; ++r)
#pragma unroll
                for (int e = 0; e < 4; ++e) acc[r][e] = 0.f;
            const float* W = p.w_ada + (size_t)l * 2048 * 6144 + n0 + 4 * cq;
#pragma unroll 8
            for (int kk = 0; kk < 64; ++kk) { const int k = ks * 64 + kk; const f32x4 w = *(const f32x4*)(W + (size_t)k * 6144);
#pragma unroll
                for (int r = 0; r < 5; ++r) { const float sv = sl[r * 2048 + k]; acc[r][0] += sv * w[0]; acc[r][1] += sv * w[1]; acc[r][2] += sv * w[2]; acc[r][3] += sv * w[3]; } }
            float* red = sl + 10240;
#pragma unroll
            for (int r = 0; r < 5; ++r)
#pragma unroll
                for (int e = 0; e < 4; ++e) red[(ks * 5 + r) * 64 + 4 * cq + e] = acc[r][e];
            __syncthreads();
            if (tid < 320) { const int r = tid >> 6, col = tid & 63; float s = 0.f;
                for (int q = 0; q < 32; ++q) s += red[(q * 5 + r) * 64 + col];
                ((float*)(p.ws + WS_MOD))[(size_t)(l * 5 + r) * 6144 + n0 + col] = s + p.b_ada[(size_t)l * 6144 + n0 + col]; }
            __syncthreads();
        } else {
            int idx = it - NG; const int l = 0;
            if (idx < TIN) transpose_tile(p.w_in + (size_t)l * D * NIN, NIN, (bf16_t*)(p.ws + WS_WINT) + (size_t)l * NINP * D, idx & 31, idx >> 5, sl);
            else { idx -= TIN; transpose_tile(p.w_out + (size_t)l * D * D, D, (bf16_t*)(p.ws + WS_WOUTT) + (size_t)l * D * D, idx & 31, idx >> 5, sl); }
        }
    }
}

static __device__ void convert_layer1_filler(const Params& p, unsigned char* shm) {
    constexpr int TIN = 29 * 32, TOUT = 8 * 32, FIRST = 32;
    float* sl = (float*)shm;
    const int nb = (int)gridDim.x > FIRST ? (int)gridDim.x - FIRST : (int)gridDim.x, b0 = (int)gridDim.x > FIRST ? (int)blockIdx.x - FIRST : (int)blockIdx.x;
    if (b0 < 0) return;
    for (int idx = b0; idx < TIN + TOUT; idx += nb) {
        if (idx < TIN) transpose_tile(p.w_in + (size_t)D * NIN, NIN, (bf16_t*)(p.ws + WS_WINT) + (size_t)NINP * D, idx & 31, idx >> 5, sl);
        else { const int j = idx - TIN; transpose_tile(p.w_out + (size_t)D * D, D, (bf16_t*)(p.ws + WS_WOUTT) + (size_t)D * D, j & 31, j >> 5, sl); }
    }
}

static __device__ void phase_ln(const Params& p, int mode) {
    const int tid_ = tid_fresh(), lane = tid_ & 63, wid = tid_ >> 6;
    const int nrows = mode == 2 ? NLAT : MROWS;
    const float* mod = (const float*)(p.ws + WS_MOD) + (mode == 1 ? 5 * 6144 : 0);
    bf16_t* H = (bf16_t*)(p.ws + WS_ACT);
    float* XC = (float*)(p.ws + WS_XC);
    const int lpost = mode == 1 ? 0 : 1;
    int nw = gridDim.x * 8; asm volatile("" : "+s"(nw));
    for (int rowa = blockIdx.x * 8 + wid; rowa < nrows; rowa += 2 * nw) {
        int rows[2] = {rowa, rowa + nw}; const bool ok1 = rows[1] < nrows; if (!ok1) rows[1] = rowa;
        float* rp[2]; const float* sp[2]; f32x4 v[2][8]; float s[2], mu[2], q[2], rstd[2];
#pragma unroll
        for (int k = 0; k < 2; ++k) { const int row = rows[k];
            if (row < NLAT) { rp[k] = p.out + (size_t)row * D; sp[k] = mode == 2 ? rp[k] : p.x + (size_t)row * D; }
            else { rp[k] = XC + (size_t)(row - NLAT) * D; sp[k] = p.ctx + (size_t)(row - NLAT) * D; } }
#pragma unroll
        for (int k = 0; k < 2; ++k) { s[k] = 0.f;
            const bf16_t* yp = (const bf16_t*)(p.ws + WS_Y) + (size_t)rows[k] * D;
            const float* gp = (const float*)(p.ws + WS_MOD) + (size_t)lpost * 5 * 6144 + 4096 + (rows[k] < NLAT ? rows[k] >> 12 : 4) * 6144;
#pragma unroll
            for (int i = 0; i < 8; ++i) { const int c = (i * 64 + lane) * 4; v[k][i] = *(const f32x4*)(sp[k] + c);
                if (mode != 0) { const u32x2 yw = *(const u32x2*)(yp + c); const f32x4 gv = *(const f32x4*)(gp + c);
                    const f32x4 yv = {bflo(yw[0]), bfhi(yw[0]), bflo(yw[1]), bfhi(yw[1])}; v[k][i] = v[k][i] * ALPHA + gv * yv; }
                s[k] += v[k][i][0] + v[k][i][1] + v[k][i][2] + v[k][i][3]; } }
#pragma unroll
        for (int k = 0; k < 2; ++k) { mu[k] = wsum(s[k]) * (1.f / 2048.f); q[k] = 0.f;
#pragma unroll
            for (int i = 0; i < 8; ++i) { v[k][i] = v[k][i] - mu[k]; q[k] += v[k][i][0] * v[k][i][0] + v[k][i][1] * v[k][i][1] + v[k][i][2] * v[k][i][2] + v[k][i][3] * v[k][i][3]; } }
#pragma unroll
        for (int k = 0; k < 2; ++k) rstd[k] = rsqrtf(wsum(q[k]) * (1.f / 2048.f) + 1e-5f);
        if (mode != 0) {
#pragma unroll
            for (int k = 0; k < 2; ++k) { s[k] = 0.f;
#pragma unroll
                for (int i = 0; i < 8; ++i) { const int c = (i * 64 + lane) * 4; const f32x4 gg = *(const f32x4*)(p.post_ln_g + lpost * D + c), bb = *(const f32x4*)(p.post_ln_b + lpost * D + c);
                    v[k][i] = v[k][i] * rstd[k] * gg + bb; if ((k == 0 || ok1) && rows[k] < NLAT) *(f32x4*)(rp[k] + c) = v[k][i]; s[k] += v[k][i][0] + v[k][i][1] + v[k][i][2] + v[k][i][3]; } }
            if (mode == 2) continue;
#pragma unroll
            for (int k = 0; k < 2; ++k) { mu[k] = wsum(s[k]) * (1.f / 2048.f); q[k] = 0.f;
#pragma unroll
                for (int i = 0; i < 8; ++i) { v[k][i] = v[k][i] - mu[k]; q[k] += v[k][i][0] * v[k][i][0] + v[k][i][1] * v[k][i][1] + v[k][i][2] * v[k][i][2] + v[k][i][3] * v[k][i][3]; } }
#pragma unroll
            for (int k = 0; k < 2; ++k) rstd[k] = rsqrtf(wsum(q[k]) * (1.f / 2048.f) + 1e-5f);
        }
#pragma unroll
        for (int k = 0; k < 2; ++k) { if (k == 1 && !ok1) break; const int row = rows[k]; const int mr = row < NLAT ? row >> 12 : 4; const float* mrow = mod + mr * 6144;
#pragma unroll
            for (int i = 0; i < 8; ++i) { const int c = (i * 64 + lane) * 4; const f32x4 sh = *(const f32x4*)(mrow + c), sc = *(const f32x4*)(mrow + 2048 + c);
                const f32x4 h = v[k][i] * rstd[k] * (sc + 1.f) + sh; u32x2 w; w[0] = cvt_pk_bf16(h[0], h[1]); w[1] = cvt_pk_bf16(h[2], h[3]);
                *(u32x2*)(H + (size_t)row * D + c) = w; } }
    }
}

__device__ __forceinline__ bf16x8 ldx8(const bf16_t* p) { return *(const bf16x8*)p; }
__device__ __forceinline__ bf16x8 ldx8(const LAS bf16_t* p) { return *(const LAS bf16x8*)p; }
template <int NB, bool LOCAL, int KLD, class KP, class VP>
__device__ __forceinline__ void attn_part(const bf16_t* __restrict__ qrow, KP kbase, size_t kblk_stride, VP vtbase, int vt_ld, int vblk_stride,
                                          const float* rpbs, int drow0, int kc0, int qc, int lq, int g, float& m_out, float& l_out, f32x4 (&O)[4]) {
    bf16x8 qf[2];
    qf[0] = *(const bf16x8*)(qrow + 8 * g); qf[1] = *(const bf16x8*)(qrow + 32 + 8 * g);
    f32x4 S[NB][2];
    const int krow = 8 * (lq >> 2) + (lq & 3);
#pragma unroll
    for (int kb = 0; kb < NB; ++kb) {
        auto kp = kbase + (size_t)kb * kblk_stride + (size_t)krow * KLD + 8 * g;
#pragma unroll
        for (int tt = 0; tt < 2; ++tt) { auto kp2 = kp + (size_t)tt * 4 * KLD;
            const bf16x8 k0 = ldx8(kp2), k1 = ldx8(kp2 + 32);
            f32x4 a = {0.f, 0.f, 0.f, 0.f}; a = mfma16(k0, qf[0], a); a = mfma16(k1, qf[1], a); S[kb][tt] = a; }
    }
    float mx = -1e30f;
    const int cs = min(max(qc - 8, 0), 48);
#pragma unroll
    for (int kb = 0; kb < NB; ++kb)
#pragma unroll
        for (int tt = 0; tt < 2; ++tt)
#pragma unroll
            for (int j = 0; j < 4; ++j) { float s = S[kb][tt][j] * 0.125f;
                if (LOCAL) { const int col = kc0 + 8 * g + 4 * tt + j; const int dc = min(max(col - qc + 15, 0), 30); const bool ok = col >= cs && col <= cs + 15;
                    const float bias = rpbs[(drow0 + kb) * 31 + dc]; s = ok ? s + bias : -1e30f; }
                S[kb][tt][j] = s; mx = fmaxf(mx, s); }
    mx = fmaxf(mx, __shfl_xor(mx, 16, 64)); mx = fmaxf(mx, __shfl_xor(mx, 32, 64));
    float l = 0.f;
#pragma unroll
    for (int kb = 0; kb < NB; ++kb)
#pragma unroll
        for (int tt = 0; tt < 2; ++tt)
#pragma unroll
            for (int j = 0; j < 4; ++j) { const float pv = __expf(S[kb][tt][j] - mx); S[kb][tt][j] = pv; l += pv; }
    l += __shfl_xor(l, 16, 64); l += __shfl_xor(l, 32, 64);
#pragma unroll
    for (int kb = 0; kb < NB; ++kb) {
        u32x4 pw; pw[0] = cvt_pk_bf16(S[kb][0][0], S[kb][0][1]); pw[1] = cvt_pk_bf16(S[kb][0][2], S[kb][0][3]); pw[2] = cvt_pk_bf16(S[kb][1][0], S[kb][1][1]); pw[3] = cvt_pk_bf16(S[kb][1][2], S[kb][1][3]);
        const bf16x8 pf = __builtin_bit_cast(bf16x8, pw);
#pragma unroll
        for (int dt = 0; dt < 4; ++dt) { const bf16x8 vf = ldx8(vtbase + (size_t)(16 * dt + lq) * vt_ld + kb * vblk_stride + 8 * g); O[dt] = mfma16(vf, pf, O[dt]); }
    }
    m_out = mx; l_out = l;
}

__device__ __forceinline__ void attn_store_row(const bf16_t* P, bf16_t* CC, size_t orow, int h, int g, const f32x4 (&O)[4], float scale) {
    const int d0 = h * 64 + 16 * g;
#pragma unroll
    for (int hf = 0; hf < 2; ++hf) { float z[8], r[8]; unpack8(*(const u32x4*)(P + orow * PS + PC_ZA + d0 + 8 * hf), z);
#pragma unroll
        for (int k = 0; k < 8; ++k) r[k] = O[k & 3][2 * hf + (k >> 2)] * scale * silu_f(z[k]);
        *(u32x4*)(CC + orow * D + d0 + 8 * hf) = pack8(r); }
}
__device__ __forceinline__ void attn_merge_store(const Params& p, float* mrg, int wid, int lane, int h, size_t orow, float m, float l, f32x4 (&O)[4]) {
    const int cb = wid & 3, lq = lane & 15, g = lane >> 4;
    if (wid >= 4) {
#pragma unroll
        for (int dt = 0; dt < 4; ++dt)
#pragma unroll
            for (int j = 0; j < 4; ++j) mrg[(cb * 18 + dt * 4 + j) * 64 + lane] = O[dt][j];
        mrg[(cb * 18 + 16) * 64 + lane] = m; mrg[(cb * 18 + 17) * 64 + lane] = l;
    }
    __syncthreads();
    if (wid < 4) {
        const float m2 = mrg[(cb * 18 + 16) * 64 + lane], l2 = mrg[(cb * 18 + 17) * 64 + lane];
        const float mm = fmaxf(m, m2), a1 = __expf(m - mm), a2 = __expf(m2 - mm), inv = __builtin_amdgcn_rcpf(a1 * l + a2 * l2);
        const bf16_t* P = (const bf16_t*)(p.ws + WS_P); bf16_t* CC = (bf16_t*)(p.ws + WS_ACT);
#pragma unroll
        for (int dt = 0; dt < 4; ++dt)
#pragma unroll
            for (int j = 0; j < 4; ++j) { const float o2 = mrg[(cb * 18 + dt * 4 + j) * 64 + lane]; O[dt][j] = a1 * O[dt][j] + a2 * o2; }
        attn_store_row(P, CC, orow, h, g, O, inv);
    }
    __syncthreads();
}

constexpr int CK_LD = 72, CV_LD = 264;
constexpr float LOG2E = 1.4426950408889634f;
__device__ __forceinline__ void na_pv(const f32x4 s0, const f32x4 s1, const bf16x8 (&vf)[4], float& l, f32x4 (&O)[4]) {
    float p[8];
#pragma unroll
    for (int j = 0; j < 4; ++j) { p[j] = __builtin_amdgcn_exp2f(s0[j]); p[4 + j] = __builtin_amdgcn_exp2f(s1[j]); }
    l += ((p[0] + p[1]) + (p[2] + p[3])) + ((p[4] + p[5]) + (p[6] + p[7]));
    u32x4 pw; pw[0] = cvt_pk_bf16(p[0], p[1]); pw[1] = cvt_pk_bf16(p[2], p[3]); pw[2] = cvt_pk_bf16(p[4], p[5]); pw[3] = cvt_pk_bf16(p[6], p[7]);
    const bf16x8 pf = __builtin_bit_cast(bf16x8, pw);
#pragma unroll
    for (int dt = 0; dt < 4; ++dt) O[dt] = mfma16(vf[dt], pf, O[dt]);
}
static __device__ void na_pair(const Params& p, unsigned char* shm, int l, int pi) {
    const int quarter = pi & 3, bh = pi >> 2, h = bh & 15, b = bh >> 4;
    float* rpbs = (float*)shm + 16;
    bf16_t* cK = (bf16_t*)(shm + 2176);
    bf16_t* cV = cK + 256 * CK_LD;
    const int tid = tid_fresh(), wid = __builtin_amdgcn_readfirstlane(tid >> 6), lane = tid & 63, lq = lane & 15, g = lane >> 4;
    const bf16_t* P = (const bf16_t*)(p.ws + WS_P);
    for (int e = tid - 16; e < 528; e += 512) rpbs[e] = e < 0 ? 0.f : (e < 465 ? p.rpb[(size_t)(l * 16 + h) * 465 + e] * LOG2E : -1e30f);
    for (int e = tid; e < 256 * 8; e += 512) { const int k = e >> 3, sg = e & 7;
        *(u32x4*)(cK + k * CK_LD + sg * 8) = *(const u32x4*)(P + ((size_t)NLAT + b * 256 + k) * PS + PC_KA + h * 64 + sg * 8); }
    { const bf16_t* vt = (const bf16_t*)(p.ws + WS_VTC) + (size_t)((b * 16 + h) * 64) * 256;
      for (int e = tid; e < 64 * 32; e += 512) { const int d = e >> 5, sg = e & 31; *(u32x4*)(cV + d * CV_LD + sg * 8) = *(const u32x4*)(vt + d * 256 + sg * 8); } }
    __syncthreads();
    const LAS bf16_t* cKl = (const LAS bf16_t*)cK; const LAS bf16_t* cVl = (const LAS bf16_t*)cV;
    const int krow = 8 * (lq >> 2) + (lq & 3);
    constexpr float SC2 = 0.125f * LOG2E;
#pragma unroll 1
    for (int wi = wid; wi < 32; wi += 8) {
        const int rA = quarter * 16 + 2 * (wi >> 2), rB = rA + 1, cb = wi & 3;
        const int RA = min(max(rA - 4, 0), 56), RB = min(max(rB - 4, 0), 56), dd = RB - RA;
        const int qc = 16 * cb + lq, cs = min(max(qc - 8, 0), 48);
        const int kc0 = cb == 0 ? 0 : (cb == 1 ? 8 : (cb == 2 ? 24 : 32));
        const size_t rowA = (size_t)b * 4096 + rA * 64 + qc, rowB = rowA + 64;
        bf16x8 qA[2], qB[2];
        { const bf16_t* qp = P + rowA * PS + PC_QA + h * 64 + 8 * g; qA[0] = *(const bf16x8*)qp; qA[1] = *(const bf16x8*)(qp + 32);
          qp += (size_t)64 * PS; qB[0] = *(const bf16x8*)qp; qB[1] = *(const bf16x8*)(qp + 32); }
        float mk[2][4]; const int bbase = kc0 + 8 * g - qc + 15;
#pragma unroll
        for (int tt = 0; tt < 2; ++tt)
#pragma unroll
            for (int j = 0; j < 4; ++j) { const int col = kc0 + 8 * g + 4 * tt + j; mk[tt][j] = (col >= cs && col <= cs + 15) ? 80.f : -1e30f; }
        f32x4 OA[4], OB[4];
#pragma unroll
        for (int dt = 0; dt < 4; ++dt) { OA[dt] = (f32x4){0.f, 0.f, 0.f, 0.f}; OB[dt] = (f32x4){0.f, 0.f, 0.f, 0.f}; }
        float lA = 0.f, lB = 0.f;
        const bf16_t* kb0 = (const bf16_t*)(p.ws + WS_KT) + (size_t)(b * 16 + h) * 262144 + (size_t)(RA * 16 + (kc0 >> 2)) * 256 + (lq >> 2) * 512 + (lq & 3) * 32 + 8 * g;
        const bf16_t* vb0 = (const bf16_t*)(p.ws + WS_VT) + (size_t)(b * 16 + h) * 262144 + (size_t)(RA * 8 + (kc0 >> 3)) * 512 + (g * 64 + lq) * 8;
        {
            const int nrows = 8 + dd;
            bf16x8 kS[2][2][2], vS[2][4];
#define NA_LDL(SL, U) do { const bf16_t* kp_ = kb0 + (size_t)(U) * 4096; \
                kS[SL][0][0] = *(const bf16x8*)kp_; kS[SL][0][1] = *(const bf16x8*)(kp_ + 128); kS[SL][1][0] = *(const bf16x8*)(kp_ + 256); kS[SL][1][1] = *(const bf16x8*)(kp_ + 384); \
                _Pragma("unroll") for (int dt_ = 0; dt_ < 4; ++dt_) vS[SL][dt_] = *(const bf16x8*)(vb0 + (size_t)(U) * 4096 + dt_ * 128); } while (0)
#define NA_ROW(SL, U) do { const int u_ = (U); const bool actA = u_ < 8, actB = u_ >= dd; \
                const int drA = actA ? min(max(RA + u_ - rA + 7, 0), 14) * 31 : 465, drB = actB ? min(max(RA + u_ - rB + 7, 0), 14) * 31 : 465; \
                f32x4 sa[2], sb[2]; \
                _Pragma("unroll") for (int tt = 0; tt < 2; ++tt) { f32x4 a = {0.f, 0.f, 0.f, 0.f}; a = mfma16(kS[SL][tt][0], qA[0], a); a = mfma16(kS[SL][tt][1], qA[1], a); \
                    f32x4 c = {0.f, 0.f, 0.f, 0.f}; c = mfma16(kS[SL][tt][0], qB[0], c); c = mfma16(kS[SL][tt][1], qB[1], c); \
                    _Pragma("unroll") for (int j = 0; j < 4; ++j) { const float ba = rpbs[drA + bbase + 4 * tt + j], bb = rpbs[drB + bbase + 4 * tt + j]; \
                        a[j] = fminf(a[j] * SC2 + ba, mk[tt][j]); c[j] = fminf(c[j] * SC2 + bb, mk[tt][j]); } \
                    sa[tt] = a; sb[tt] = c; } \
                na_pv(sa[0], sa[1], vS[SL], lA, OA); na_pv(sb[0], sb[1], vS[SL], lB, OB); } while (0)
            NA_LDL(0, 0);
#pragma unroll 1
            for (int u = 0; u < 8; u += 2) {
                NA_LDL(1, u + 1);
                NA_ROW(0, u);
                if (u + 2 < nrows) NA_LDL(0, u + 2);
                NA_ROW(1, u + 1);
            }
            if (dd) NA_ROW(0, 8);
#undef NA_ROW
#undef NA_LDL
        }
        {
            bf16x8 kS[2][2][2], vS[2][4];
#define NA_LDC(SL, KB) do { const LAS bf16_t* kp_ = cKl + ((KB) * 32 + krow) * CK_LD + 8 * g; \
                kS[SL][0][0] = *(const LAS bf16x8*)kp_; kS[SL][0][1] = *(const LAS bf16x8*)(kp_ + 32); kS[SL][1][0] = *(const LAS bf16x8*)(kp_ + 4 * CK_LD); kS[SL][1][1] = *(const LAS bf16x8*)(kp_ + 4 * CK_LD + 32); \
                _Pragma("unroll") for (int dt_ = 0; dt_ < 4; ++dt_) vS[SL][dt_] = *(const LAS bf16x8*)(cVl + (16 * dt_ + lq) * CV_LD + (KB) * 32 + 8 * g); } while (0)
#define NA_CTX(SL) do { f32x4 sa[2], sb[2]; \
                _Pragma("unroll") for (int tt = 0; tt < 2; ++tt) { f32x4 a = {0.f, 0.f, 0.f, 0.f}; a = mfma16(kS[SL][tt][0], qA[0], a); a = mfma16(kS[SL][tt][1], qA[1], a); \
                    f32x4 c = {0.f, 0.f, 0.f, 0.f}; c = mfma16(kS[SL][tt][0], qB[0], c); c = mfma16(kS[SL][tt][1], qB[1], c); \
                    _Pragma("unroll") for (int j = 0; j < 4; ++j) { a[j] = fminf(a[j] * SC2, 80.f); c[j] = fminf(c[j] * SC2, 80.f); } \
                    sa[tt] = a; sb[tt] = c; } \
                na_pv(sa[0], sa[1], vS[SL], lA, OA); na_pv(sb[0], sb[1], vS[SL], lB, OB); } while (0)
            NA_LDC(0, 0);
#pragma unroll 1
            for (int kb = 0; kb < 8; kb += 2) {
                NA_LDC(1, kb + 1);
                NA_CTX(0);
                if (kb + 2 < 8) NA_LDC(0, kb + 2);
                NA_CTX(1);
            }
#undef NA_CTX
#undef NA_LDC
        }
        lA += __shfl_xor(lA, 16, 64); lA += __shfl_xor(lA, 32, 64); lB += __shfl_xor(lB, 16, 64); lB += __shfl_xor(lB, 32, 64);
        const float iA = __builtin_amdgcn_rcpf(lA), iB = __builtin_amdgcn_rcpf(lB);
        bf16_t* CC = (bf16_t*)(p.ws + WS_ACT);
        attn_store_row(P, CC, rowA, h, g, OA, iA);
        attn_store_row(P, CC, rowB, h, g, OB, iB);
    }
    __syncthreads();
}

static __device__ void ctxattn_item(const Params& p, unsigned char* shm, int item) {
    const int qb = item & 3, h = (item >> 2) & 15, b = item >> 6;
    float* mrg = (float*)shm + 512;
    const int tid = tid_fresh(), wid = tid >> 6, lane = tid & 63, lq = lane & 15, g = lane >> 4, cb = wid & 3;
    const bf16_t* P = (const bf16_t*)(p.ws + WS_P);
    const size_t orow = (size_t)NLAT + b * 256 + qb * 64 + 16 * cb + lq;
    const bf16_t* qrow = P + orow * PS + PC_QA + h * 64;
    f32x4 O[4];
#pragma unroll
    for (int dt = 0; dt < 4; ++dt) O[dt] = (f32x4){0.f, 0.f, 0.f, 0.f};
    float m, lsum;
    const int koff = wid < 4 ? 0 : 128;
    const bf16_t* kbase = P + ((size_t)NLAT + b * 256 + koff) * PS + PC_KA + h * 64;
    const bf16_t* vtbase = (const bf16_t*)(p.ws + WS_VTC) + (size_t)((b * 16 + h) * 64) * 256 + koff;
    attn_part<4, false, PS>(qrow, kbase, (size_t)32 * PS, vtbase, 256, 32, (const float*)shm, 0, 0, 0, lq, g, m, lsum, O);
    attn_merge_store(p, mrg, wid, lane, h, orow, m, lsum, O);
}

static __device__ void conv_item(const Params& p, unsigned char* shm, int l, int item) {
    int b, t0, Lseq; size_t rowbase;
    if (item < 512) { b = item >> 7; t0 = (item & 127) * 32; Lseq = SEQ; rowbase = (size_t)b * 4096; }
    else { const int j = item - 512; b = j >> 3; t0 = (j & 7) * 32; Lseq = LC; rowbase = (size_t)NLAT + b * 256; }
    float* u = (float*)shm;
    const bf16_t* P = (const bf16_t*)(p.ws + WS_P); bf16_t* CC = (bf16_t*)(p.ws + WS_ACT);
    const int tid = tid_fresh(), wid = tid >> 6, lane = tid & 63;
    u32x4 ra[8], rg[8];
#pragma unroll
    for (int it = 0; it < 8; ++it) { const int e = tid + it * 512, tt = e >> 6, c8 = (e & 63) * 8, t = t0 - 15 + tt;
        ra[it] = (u32x4){0u, 0u, 0u, 0u}; rg[it] = (u32x4){0u, 0u, 0u, 0u};
        if (tt < 62 && t >= 0 && t < Lseq) { const bf16_t* rp = P + (rowbase + t) * PS; ra[it] = *(const u32x4*)(rp + PC_CA + c8); rg[it] = *(const u32x4*)(rp + PC_CG + c8); } }
    float w[31];
#pragma unroll
    for (int j = 0; j < 31; ++j) w[j] = p.conv_w[(size_t)(l * 31 + j) * 512 + tid];
    const float bias = p.conv_b[l * 512 + tid];
#pragma unroll
    for (int it = 0; it < 8; ++it) { const int e = tid + it * 512, tt = e >> 6, c8 = (e & 63) * 8;
        if (tt < 62) { float a[8], gt[8], f[8]; unpack8(ra[it], a); unpack8(rg[it], gt);
#pragma unroll
            for (int k = 0; k < 8; ++k) f[k] = a[k] * sigm_f(gt[k]);
            *(f32x4*)(u + tt * 512 + c8) = (f32x4){f[0], f[1], f[2], f[3]}; *(f32x4*)(u + tt * 512 + c8 + 4) = (f32x4){f[4], f[5], f[6], f[7]}; } }
    __syncthreads();
    unsigned zc[4][4];
#pragma unroll
    for (int q = 0; q < 4; ++q)
#pragma unroll
        for (int k = 0; k < 4; ++k) zc[q][k] = *(const unsigned*)(P + (rowbase + t0 + wid * 4 + q) * PS + PC_ZC + 2 * (lane + 64 * k));
    {
        const int ch = tid; typedef float f2 __attribute__((ext_vector_type(2)));
        f2 wp[32], acc2[16];
#pragma unroll
        for (int m = 0; m < 32; ++m) wp[m] = (f2){m <= 30 ? w[m] : 0.f, m >= 1 ? w[m - 1] : 0.f};
#pragma unroll
        for (int k = 0; k < 16; ++k) acc2[k] = (f2){bias, bias};
#pragma unroll
        for (int tt = 0; tt < 62; ++tt) { const float val = u[tt * 512 + ch]; const f2 v2 = {val, val};
#pragma unroll
            for (int k = 0; k < 16; ++k) { const int m = tt - 2 * k; if (m >= 0 && m <= 31) acc2[k] = wp[m] * v2 + acc2[k]; } }
#pragma unroll
        for (int k = 0; k < 16; ++k) { u[(2 * k) * 512 + ch] = acc2[k][0]; u[(2 * k + 1) * 512 + ch] = acc2[k][1]; }
    }
    __syncthreads();
    float lg[8], lb[8];
#pragma unroll
    for (int k = 0; k < 4; ++k) { const int ch = 2 * (lane + 64 * k); lg[2 * k] = p.conv_ln_g[l * 512 + ch]; lg[2 * k + 1] = p.conv_ln_g[l * 512 + ch + 1]; lb[2 * k] = p.conv_ln_b[l * 512 + ch]; lb[2 * k + 1] = p.conv_ln_b[l * 512 + ch + 1]; }
#pragma unroll
    for (int q = 0; q < 4; ++q) { const int t = wid * 4 + q; float v[8], s = 0.f;
#pragma unroll
        for (int k = 0; k < 4; ++k) { v[2 * k] = u[t * 512 + 2 * (lane + 64 * k)]; v[2 * k + 1] = u[t * 512 + 2 * (lane + 64 * k) + 1]; s += v[2 * k] + v[2 * k + 1]; }
        const float mu = wsum(s) * (1.f / 512.f); float qq = 0.f;
#pragma unroll
        for (int i = 0; i < 8; ++i) { v[i] -= mu; qq += v[i] * v[i]; }
        const float rstd = rsqrtf(wsum(qq) * (1.f / 512.f) + 1e-5f);
        const size_t row = rowbase + t0 + t;
#pragma unroll
        for (int k = 0; k < 4; ++k) { const float y0 = v[2 * k] * rstd * lg[2 * k] + lb[2 * k], y1 = v[2 * k + 1] * rstd * lg[2 * k + 1] + lb[2 * k + 1];
            *(unsigned*)(CC + row * D + 1536 + 2 * (lane + 64 * k)) = cvt_pk_bf16(silu_f(y0) * silu_f(bflo(zc[q][k])), silu_f(y1) * silu_f(bfhi(zc[q][k]))); } }
    __syncthreads();
}

__device__ __forceinline__ f32x4 mma_lds(const bf16_t* A, int lda, const bf16_t* B, int ldb, int K, int lq, int g, f32x4 acc) {
    for (int k0 = 0; k0 < K; k0 += 32) { const bf16x8 a = *(const bf16x8*)(A + lq * lda + k0 + 8 * g), b = *(const bf16x8*)(B + lq * ldb + k0 + 8 * g); acc = mfma16(a, b, acc); }
    return acc;
}
__device__ __forceinline__ size_t gla_row0(int b, int ci) { return ci < 4 ? (size_t)NLAT + b * 256 + ci * 64 : (size_t)b * 4096 + (ci - 4) * 64; }
__device__ __forceinline__ void gla_load_rope(const Params& p, int tid, float* dst, size_t row0, int colbase, int ci, float scale) {
    const int c = tid >> 3, seg = tid & 7;
    const bf16_t* rp = (const bf16_t*)(p.ws + WS_P) + (row0 + c) * PS + colbase;
    float own[8]; unpack8(*(const u32x4*)(rp + seg * 8), own);
    if (ci >= 4) { float oth[8]; unpack8(*(const u32x4*)(rp + (seg ^ 2) * 8), oth);
        const float* rope = (const float*)(p.ws + WS_ROPE); const int pos = seg < 4 ? ci - 4 : c; const int i0 = (seg & 1) * 8;
        const f32x4 c0 = *(const f32x4*)(rope + pos * 16 + i0), c1 = *(const f32x4*)(rope + pos * 16 + i0 + 4), s0 = *(const f32x4*)(rope + 1024 + pos * 16 + i0), s1 = *(const f32x4*)(rope + 1024 + pos * 16 + i0 + 4);
        const float csv[8] = {c0[0], c0[1], c0[2], c0[3], c1[0], c1[1], c1[2], c1[3]}, snv[8] = {s0[0], s0[1], s0[2], s0[3], s1[0], s1[1], s1[2], s1[3]};
#pragma unroll
        for (int e = 0; e < 8; ++e) { const float cs = csv[e], sn = snv[e];
            own[e] = (seg & 2) ? oth[e] * sn + own[e] * cs : own[e] * cs - oth[e] * sn; } }
    *(f32x4*)(dst + c * 64 + seg * 8) = (f32x4){own[0] * scale, own[1] * scale, own[2] * scale, own[3] * scale};
    *(f32x4*)(dst + c * 64 + seg * 8 + 4) = (f32x4){own[4] * scale, own[5] * scale, own[6] * scale, own[7] * scale};
}
__device__ __forceinline__ void gla_load_vT(const Params& p, int tid, bf16_t* VTs, size_t row0, int h) {
    for (int e = tid; e < 1024; e += 512) { const int c = e >> 4, seg = e & 15;
        const u32x4 w = *(const u32x4*)((const bf16_t*)(p.ws + WS_P) + (row0 + c) * PS + PC_VB + h * 128 + seg * 8);
#pragma unroll
        for (int k = 0; k < 4; ++k) { VTs[(seg * 8 + 2 * k) * 72 + c] = (bf16_t)(w[k] & 0xffffu); VTs[(seg * 8 + 2 * k + 1) * 72 + c] = (bf16_t)(w[k] >> 16); } }
}
__device__ __forceinline__ void gla_stage_gate(const Params& p, int tid, float* w2s, bf16_t* lrs, int l, int h, size_t row0) {
    { const int row = tid >> 4, ch = (tid & 15) * 4; *(f32x4*)(w2s + row * 64 + ch) = *(const f32x4*)(p.gla_w2 + (size_t)(l * 32 + row) * 256 + h * 64 + ch); }
    if (tid < 256) { const int tok = tid >> 2, ch = (tid & 3) * 8; *(u32x4*)(lrs + tok * 32 + ch) = *(const u32x4*)((const bf16_t*)(p.ws + WS_P) + (row0 + tok) * PS + PC_GLR + ch); }
}
__device__ __forceinline__ float gla_g8(const Params& p, int tid, const float* w2s, const bf16_t* lrs, int l, int h, int dir, float (&bl)[8]) {
    const int dk = tid & 63, cgp = tid >> 6;
    float w2r[16];
#pragma unroll
    for (int r = 0; r < 16; ++r) w2r[r] = w2s[(dir * 16 + r) * 64 + dk];
    const float bias = p.gla_b[(l * 2 + dir) * 256 + h * 64 + dk];
    float gv[8];
#pragma unroll
    for (int cc = 0; cc < 8; ++cc) { const bf16_t* lp = lrs + (cgp * 8 + cc) * 32 + dir * 16;
        float t0[8], t1[8]; unpack8(*(const u32x4*)lp, t0); unpack8(*(const u32x4*)(lp + 8), t1);
        float x = bias;
#pragma unroll
        for (int r = 0; r < 8; ++r) x += t0[r] * w2r[r] + t1[r] * w2r[8 + r];
        gv[cc] = (fminf(x, 0.f) - __logf(1.f + __expf(-fabsf(x)))) * (1.f / 16.f); }
    float tot = 0.f;
    if (dir == 0) {
#pragma unroll
        for (int cc = 0; cc < 8; ++cc) { tot += gv[cc]; bl[cc] = tot; }
    } else {
#pragma unroll
        for (int cc = 7; cc >= 0; --cc) { tot += gv[cc]; bl[cc] = tot; }
    }
    return tot;
}

static __device__ void gla_g1_item(const Params& p, unsigned char* shm, int l, int item) {
    const int ci = item % NCHUNK, bh = item / NCHUNK, h = bh & 3, b = bh >> 2;
    float* kf = (float*)shm;
    float* part = kf + 4096;
    bf16_t* VTs = (bf16_t*)(part + 1024);
    bf16_t* KdT = VTs + 128 * 72;
    const int tid = tid_fresh(), wid = tid >> 6, lane = tid & 63, lq = lane & 15, g = lane >> 4, dk = tid & 63, cgp = tid >> 6;
    const size_t row0 = gla_row0(b, ci);
    float* w2s = (float*)(KdT + 2 * 64 * 72);
    bf16_t* lrs = (bf16_t*)(w2s + 2048);
    gla_load_rope(p, tid, kf, row0, PC_KB + h * 64, ci, 1.f);
    gla_load_vT(p, tid, VTs, row0, h);
    gla_stage_gate(p, tid, w2s, lrs, l, h, row0);
    __syncthreads();
    float bl[2][8];
#pragma unroll
    for (int dir = 0; dir < 2; ++dir) part[(dir * 8 + cgp) * 64 + dk] = gla_g8(p, tid, w2s, lrs, l, h, dir, bl[dir]);
    __syncthreads();
#pragma unroll
    for (int dir = 0; dir < 2; ++dir) {
        float off = 0.f, btot = 0.f;
#pragma unroll
        for (int q = 0; q < 8; ++q) { const float pv = part[(dir * 8 + q) * 64 + dk]; btot += pv; if (dir == 0 ? q < cgp : q > cgp) off += pv; }
        const size_t sidx = (size_t)((dir * 4 + b) * 4 + h) * NCHUNK + ci;
        float f[8];
#pragma unroll
        for (int cc = 0; cc < 8; ++cc) { const float bv = bl[dir][cc] + off; f[cc] = kf[(cgp * 8 + cc) * 64 + dk] * __expf(btot - bv); }
        *(u32x4*)(KdT + (dir * 64 + dk) * 72 + cgp * 8) = pack8(f);
        if (cgp == 0) ((float*)(p.ws + WS_DEC))[sidx * 64 + dk] = __expf(btot);
    }
    __syncthreads();
#pragma unroll
    for (int dir = 0; dir < 2; ++dir) {
        const size_t sidx = (size_t)((dir * 4 + b) * 4 + h) * NCHUNK + ci;
        float* KV = (float*)(p.ws + WS_KVT) + sidx * 8192;
#pragma unroll
        for (int nt = 0; nt < 4; ++nt) { f32x4 acc = {0.f, 0.f, 0.f, 0.f}; acc = mma_lds(VTs + (16 * wid) * 72, 72, KdT + (dir * 64 + 16 * nt) * 72, 72, 64, lq, g, acc);
#pragma unroll
            for (int j = 0; j < 4; ++j) KV[(16 * wid + 4 * g + j) * 64 + 16 * nt + lq] = acc[j]; }
    }
    __syncthreads();
}

static __device__ void gla_scan_item(const Params& p, int item) {
    const int slab = item & 15, seq = item >> 4, dir = seq >> 4;
    const int e = slab * 512 + tid_fresh(), dk = e & 63;
    const float* KV = (const float*)(p.ws + WS_KVT) + (size_t)seq * NCHUNK * 8192 + e;
    bf16_t* KVS = (bf16_t*)(p.ws + WS_KVS) + (size_t)seq * NCHUNK * 8192 + e;
    const float* DEC = (const float*)(p.ws + WS_DEC) + (size_t)seq * NCHUNK * 64 + dk;
    float s = 0.f;
#pragma unroll 1
    for (int s0 = 0; s0 < NCHUNK; s0 += 17) { float kv[17], dc[17];
#pragma unroll
        for (int q = 0; q < 17; ++q) { const int st = s0 + q; const int ci = dir == 0 ? st : (st < 4 ? 3 - st : 71 - st); kv[q] = KV[(size_t)ci * 8192]; dc[q] = DEC[ci * 64]; }
#pragma unroll
        for (int q = 0; q < 17; ++q) { const int st = s0 + q; const int ci = dir == 0 ? st : (st < 4 ? 3 - st : 71 - st); KVS[(size_t)ci * 8192] = f2bf(s); s = dc[q] * s + kv[q]; } }
}

__device__ __forceinline__ void gla_cum(const Params& p, int tid, float* part, int l, int h, int dir, size_t row0, float (&bl)[8], float& btot) {
    const int dk = tid & 63, cgp = tid >> 6;
    float w2r[16];
#pragma unroll
    for (int r = 0; r < 16; ++r) w2r[r] = p.gla_w2[(size_t)((l * 2 + dir) * 16 + r) * 256 + h * 64 + dk];
    const float bias = p.gla_b[(l * 2 + dir) * 256 + h * 64 + dk];
    float gv[8];
#pragma unroll
    for (int cc = 0; cc < 8; ++cc) { const bf16_t* lp = (const bf16_t*)(p.ws + WS_P) + (row0 + cgp * 8 + cc) * PS + PC_GLR + dir * 16;
        float lr[16]; { float t8[8]; unpack8(*(const u32x4*)lp, t8);
#pragma unroll
            for (int e = 0; e < 8; ++e) lr[e] = t8[e];
            unpack8(*(const u32x4*)(lp + 8), t8);
#pragma unroll
            for (int e = 0; e < 8; ++e) lr[8 + e] = t8[e]; }
        float x = bias;
#pragma unroll
        for (int r = 0; r < 16; ++r) x += lr[r] * w2r[r];
        gv[cc] = (fminf(x, 0.f) - __logf(1.f + __expf(-fabsf(x)))) * (1.f / 16.f); }
    float tot = 0.f;
    if (dir == 0) {
#pragma unroll
        for (int cc = 0; cc < 8; ++cc) { tot += gv[cc]; bl[cc] = tot; }
    } else {
#pragma unroll
        for (int cc = 7; cc >= 0; --cc) { tot += gv[cc]; bl[cc] = tot; }
    }
    part[cgp * 64 + dk] = tot;
    __syncthreads();
    float off = 0.f; btot = 0.f;
#pragma unroll
    for (int q = 0; q < 8; ++q) { const float pv = part[q * 64 + dk]; btot += pv; if (dir == 0 ? q < cgp : q > cgp) off += pv; }
#pragma unroll
    for (int cc = 0; cc < 8; ++cc) bl[cc] += off;
}

static __device__ void gla_g3_item(const Params& p, unsigned char* shm, int l, int b, int h, int ci) {
    float* qf = (float*)shm;
    float* kf = qf + 4096;
    float* part = kf + 4096;
    bf16_t* VTs = (bf16_t*)(part + 1024);
    bf16_t* STs = VTs + 128 * 72;
    bf16_t* qt = STs + 2 * 128 * 72;
    bf16_t* kt = qt + 64 * 72;
    bf16_t* att = kt + 64 * 72;
    float* osh = qf;
    const int tid = tid_fresh(), wid = tid >> 6, lane = tid & 63, lq = lane & 15, g = lane >> 4, dk = tid & 63, cgp = tid >> 6;
    const size_t row0 = gla_row0(b, ci);
    gla_load_rope(p, tid, qf, row0, PC_QB + h * 64, ci, 0.125f);
    gla_load_rope(p, tid, kf, row0, PC_KB + h * 64, ci, 1.f);
    gla_load_vT(p, tid, VTs, row0, h);
    float* w2s = (float*)(att + 64 * 72);
    bf16_t* lrs = (bf16_t*)(w2s + 2048);
    gla_stage_gate(p, tid, w2s, lrs, l, h, row0);
#pragma unroll
    for (int dir = 0; dir < 2; ++dir) { const bf16_t* KVS = (const bf16_t*)(p.ws + WS_KVS) + ((size_t)((dir * 4 + b) * 4 + h) * NCHUNK + ci) * 8192;
#pragma unroll
        for (int q = 0; q < 2; ++q) { const int e8 = (q * 512 + tid) * 8; *(u32x4*)(STs + (dir * 128 + (e8 >> 6)) * 72 + (e8 & 63)) = *(const u32x4*)(KVS + e8); } }
    f32x4 oacc[4];
#pragma unroll
    for (int it = 0; it < 4; ++it) oacc[it] = (f32x4){0.f, 0.f, 0.f, 0.f};
    __syncthreads();
    float blv[2][8];
#pragma unroll
    for (int dir = 0; dir < 2; ++dir) part[(dir * 8 + cgp) * 64 + dk] = gla_g8(p, tid, w2s, lrs, l, h, dir, blv[dir]);
    __syncthreads();
#pragma unroll
    for (int dir = 0; dir < 2; ++dir) {
        float off = 0.f;
#pragma unroll
        for (int q = 0; q < 8; ++q) { const float pv = part[(dir * 8 + q) * 64 + dk]; if (dir == 0 ? q < cgp : q > cgp) off += pv; }
#pragma unroll
        for (int cc = 0; cc < 8; ++cc) { const int c = cgp * 8 + cc; const float bv = blv[dir][cc] + off; qt[c * 72 + dk] = f2bf(qf[c * 64 + dk] * __expf(bv)); kt[c * 72 + dk] = f2bf(kf[c * 64 + dk] * __expf(-bv)); }
        __syncthreads();
        { const int it = wid >> 1;
#pragma unroll
          for (int q = 0; q < 2; ++q) { const int jt = 2 * (wid & 1) + q; f32x4 a = {0.f, 0.f, 0.f, 0.f}; a = mma_lds(qt + (16 * it) * 72, 72, kt + (16 * jt) * 72, 72, 64, lq, g, a);
#pragma unroll
              for (int j = 0; j < 4; ++j) { const int i = 16 * it + 4 * g + j, jj = 16 * jt + lq; const bool keep = dir == 0 ? jj <= i : jj >= i; att[i * 72 + jj] = f2bf(keep ? a[j] : 0.f); } } }
        __syncthreads();
#pragma unroll
        for (int it = 0; it < 4; ++it) { oacc[it] = mma_lds(qt + (16 * it) * 72, 72, STs + (dir * 128 + 16 * wid) * 72, 72, 64, lq, g, oacc[it]);
            oacc[it] = mma_lds(att + (16 * it) * 72, 72, VTs + (16 * wid) * 72, 72, 64, lq, g, oacc[it]); }
        __syncthreads();
    }
    const bf16_t* P = (const bf16_t*)(p.ws + WS_P); bf16_t* CC = (bf16_t*)(p.ws + WS_ACT);
    unsigned zz[8];
#pragma unroll
    for (int q = 0; q < 8; ++q) { const size_t row = row0 + wid * 8 + q; zz[q] = *(const unsigned*)(P + row * PS + PC_ZB + h * 128 + 2 * lane); }
    const float gn0 = p.gla_norm[l * 128 + 2 * lane], gn1 = p.gla_norm[l * 128 + 2 * lane + 1];
#pragma unroll
    for (int it = 0; it < 4; ++it)
#pragma unroll
        for (int j = 0; j < 4; ++j) osh[(16 * it + 4 * g + j) * 128 + 16 * wid + lq] = oacc[it][j];
    __syncthreads();
#pragma unroll
    for (int q = 0; q < 8; ++q) { const int c = wid * 8 + q; const float o0 = osh[c * 128 + 2 * lane], o1 = osh[c * 128 + 2 * lane + 1];
        const float ms = wsum(o0 * o0 + o1 * o1) * (1.f / 128.f); const float rr = rsqrtf(ms + 1e-6f);
        const size_t row = row0 + c;
        *(unsigned*)(CC + row * D + 1024 + h * 128 + 2 * lane) = cvt_pk_bf16(o0 * rr * gn0 * silu_f(bflo(zz[q])), o1 * rr * gn1 * silu_f(bfhi(zz[q]))); }
    __syncthreads();
}

#ifndef ONLY
#define EN(k) 1
#else
#define EN(k) (ONLY==(k))
#endif
template <int SUB> __device__ __forceinline__ void run_sub(const Params& p, unsigned char* shm, const int l) {
    const int G = gridDim.x, bid = blockIdx.x;
    if constexpr (SUB == 0) {
        pg8::Gemm gm{(const bf16_t*)(p.ws + WS_ACT), (const bf16_t*)(p.ws + WS_WINT) + (size_t)l * NINP * D, MROWS, NINP, D};
        pg8::StaticOrder S; S.init(gm.M, gm.N, G, bid);
        EpiIn E{(bf16_t*)(p.ws + WS_P), (bf16_t*)(p.ws + WS_VT), (bf16_t*)(p.ws + WS_VTC), (bf16_t*)(p.ws + WS_KT)};
        pg8::gemm_phase<EpiIn>((LAS unsigned char*)shm, gm, S, E);
    } else if constexpr (SUB == 1) {
        for (int pi = bid; pi < 256; pi += G) na_pair(p, shm, l, pi);
        const int n_ca = l == 0 ? 256 : 0, n_cv = l == 0 ? 544 : 512, n_g1 = 16 * NCHUNK;
        const int total = n_ca + n_cv + n_g1;
        for (int it = bid; it < total; it += G) {
            int i = it;
            if (i < n_ca) { ctxattn_item(p, shm, i); continue; } i -= n_ca;
            if (i < n_cv) { conv_item(p, shm, l, i); continue; } i -= n_cv;
            gla_g1_item(p, shm, l, i);
        }
    } else if constexpr (SUB == 2) {
        for (int it = bid; it < 512; it += G) gla_scan_item(p, it);
    } else if constexpr (SUB == 3) {
        const int nch = l == 0 ? NCHUNK : 64, total = 16 * nch;
        for (int it = bid; it < total; it += G) { const int bh = it / nch, cix = it % nch; gla_g3_item(p, shm, l, bh >> 2, bh & 3, l == 0 ? cix : cix + 4); }
    } else if constexpr (SUB == 4) {
        pg8::Gemm gm{(const bf16_t*)(p.ws + WS_ACT), (const bf16_t*)(p.ws + WS_WOUTT) + (size_t)l * D * D, l == 0 ? MROWS : NLAT, D, D};
        pg8::StaticOrder S; S.init(gm.M, gm.N, G, bid);
        EpiOutY E{(bf16_t*)(p.ws + WS_Y)};
        pg8::gemm_phase<EpiOutY>((LAS unsigned char*)shm, gm, S, E);
        if (l == 0) convert_layer1_filler(p, shm);
    } else {
        phase_ln(p, l == 0 ? 1 : 2);
    }
}
#define XB_TMO      128
#define XB_XCNT(j)  (256  + 64 * (j))
#define XB_XSUB(j)  (1280 + 64 * (j))
#define XB_XGEN(j)  (2304 + 64 * (j))
#define XB_TOP      3328
#define XB_TOPGEN   3392
#define XB_SPIN_CAP (1u << 18)
__device__ __forceinline__ unsigned xb_ld(unsigned* p)              { return __hip_atomic_load(p, __ATOMIC_RELAXED, __HIP_MEMORY_SCOPE_AGENT); }
__device__ __forceinline__ unsigned xb_add(unsigned* p, unsigned v) { return __hip_atomic_fetch_add(p, v, __ATOMIC_RELAXED, __HIP_MEMORY_SCOPE_AGENT); }
__device__ __forceinline__ unsigned xb_xcc_id() { return (unsigned)__builtin_amdgcn_s_getreg((3 << 11) | 20) & 0xFu; }
#define XB_SPIN(cond, bar) do { unsigned _sp = 0; while (cond) { __builtin_amdgcn_s_sleep(1); \
    if ((++_sp & 255u) == 0u) { if (xb_ld(&(bar)[XB_TMO])) break; if (_sp > XB_SPIN_CAP) { atomicAdd(&(bar)[XB_TMO], 1u); break; } } } } while (0)
__device__ __forceinline__ void xcd_barrier_complete(unsigned* bar, unsigned x, unsigned& nloc, unsigned& nx) {
    const unsigned G = gridDim.x * gridDim.y * gridDim.z;
    unsigned sum, cnt, mine, sp = 0u;
    for (;;) {
        sum = 0u; cnt = 0u; mine = 0u;
#pragma unroll
        for (unsigned j = 0; j < 16; ++j) { const unsigned c = xb_ld(&bar[XB_XCNT(j)]); sum += c; cnt += (c > 0u) ? 1u : 0u; mine = (j == x) ? c : mine; }
        if (sum == G) break;
        __builtin_amdgcn_s_sleep(1);
        if ((++sp & 255u) == 0u) { if (xb_ld(&bar[XB_TMO])) break; if (sp > XB_SPIN_CAP) { atomicAdd(&bar[XB_TMO], 1u); break; } }
    }
    nloc = mine > 0u ? mine : 1u; nx = cnt > 0u ? cnt : 1u;
}
__device__ __forceinline__ void xcd_barrier(unsigned* bar, volatile LAS unsigned* st) {
    asm volatile("s_waitcnt vmcnt(0)" ::: "memory");
    __syncthreads();
    if (threadIdx.x == 0) {
        const unsigned x = xb_xcc_id();
        __builtin_amdgcn_s_waitcnt(0);
        unsigned nloc = st[0], nx = st[1];
        if (nloc == 0u) { xcd_barrier_complete(bar, x, nloc, nx); st[0] = nloc; st[1] = nx; }
        const unsigned old = xb_add(&bar[XB_XSUB(x)], 1u);
        const unsigned gen = old / nloc;
        if (old + 1u == (gen + 1u) * nloc) {
            __builtin_amdgcn_fence(__ATOMIC_RELEASE, "agent");
            asm volatile("s_waitcnt vmcnt(0)" ::: "memory");
            const unsigned og = xb_add(&bar[XB_TOP], 1u);
            const unsigned tg = og / nx;
            if (og + 1u == (tg + 1u) * nx) xb_add(&bar[XB_TOPGEN], 1u);
            else XB_SPIN(xb_ld(&bar[XB_TOPGEN]) == tg, bar);
            __builtin_amdgcn_fence(__ATOMIC_ACQUIRE, "agent");
            xb_add(&bar[XB_XGEN(x)], 1u);
            asm volatile("s_waitcnt vmcnt(0)" ::: "memory");
        } else {
            XB_SPIN(xb_ld(&bar[XB_XGEN(x)]) == gen, bar);
            __builtin_amdgcn_fence(__ATOMIC_ACQUIRE, "agent");
            asm volatile("s_waitcnt vmcnt(0)" ::: "memory");
        }
    }
    __syncthreads();
}

__device__ __forceinline__ unsigned long long ld_u64(const unsigned* lp, int i) {
    const unsigned lo = (unsigned)__builtin_amdgcn_readfirstlane((int)lp[2 * i]), hi = (unsigned)__builtin_amdgcn_readfirstlane((int)lp[2 * i + 1]);
    return ((unsigned long long)hi << 32) | lo;
}
#define GPTR(T, i) ((T*)(__attribute__((address_space(1))) T*)ld_u64(lp, (i)))
__device__ __forceinline__ void load_params(Params& q, unsigned char* shm) {
    const unsigned* lp = (const unsigned*)(shm + LDS_BYTES - 256);
    asm volatile("" : "+v"(lp) :: "memory");
    q.x = GPTR(const float, 0); q.c = GPTR(const float, 1); q.ctx = GPTR(const float, 2); q.c_ctx = GPTR(const float, 3);
    q.w_ada = GPTR(const float, 4); q.b_ada = GPTR(const float, 5); q.w_in = GPTR(const float, 6); q.rpb = GPTR(const float, 7);
    q.gla_w2 = GPTR(const float, 8); q.gla_b = GPTR(const float, 9); q.gla_norm = GPTR(const float, 10); q.conv_w = GPTR(const float, 11);
    q.conv_b = GPTR(const float, 12); q.conv_ln_g = GPTR(const float, 13); q.conv_ln_b = GPTR(const float, 14); q.w_out = GPTR(const float, 15);
    q.post_ln_g = GPTR(const float, 16); q.post_ln_b = GPTR(const float, 17); q.out = GPTR(float, 18); q.ws = GPTR(unsigned char, 19);
    q.ph_lo = 0; q.ph_hi = 0;
}
__global__ void __launch_bounds__(512, 2) fwd_megakernel(Params p) {
    extern __shared__ __attribute__((aligned(16))) unsigned char shm[];
    cg::grid_group grid = cg::this_grid();
    if (threadIdx.x < sizeof(Params) / 4) ((unsigned*)(shm + LDS_BYTES - 256))[threadIdx.x] = ((const unsigned*)&p)[threadIdx.x];
    volatile LAS unsigned* xst = (volatile LAS unsigned*)((LAS unsigned char*)shm + LDS_BYTES - 64);
    if (threadIdx.x == 0) { xst[0] = 0u; xst[1] = 0u; }
    __syncthreads();
    if (threadIdx.x == 0) (void)xb_add(&((unsigned*)(p.ws + WS_BAR))[XB_XCNT(xb_xcc_id())], 1u);
    const int ph_lo = p.ph_lo, ph_hi = p.ph_hi;
#ifndef REPMASK
#define REPMASK 0
#endif
#define GSYNC_CG() do { asm volatile("" ::: "memory"); grid.sync(); asm volatile("" ::: "memory"); } while (0)
#define GSYNC_X() do { unsigned* bar_ = (unsigned*)(__attribute__((address_space(1))) unsigned*)(ld_u64((const unsigned*)(shm + LDS_BYTES - 256), 19) + WS_BAR); xcd_barrier(bar_, xst); } while (0)
#define SEAM_X() do { const unsigned* lp_ = (const unsigned*)(shm + LDS_BYTES - 256); asm volatile("" : "+v"(lp_) :: "memory"); unsigned* bar_ = (unsigned*)(__attribute__((address_space(1))) unsigned*)(ld_u64(lp_, 19) + WS_BAR); xcd_barrier(bar_, xst); } while (0)
    { Params q; load_params(q, shm); phase_prep(q, shm); }
    if (ph_lo != 0) GSYNC_CG();
    SEAM_X();
    { Params q; load_params(q, shm); phase_ln(q, 0); }
#pragma unroll 1
    for (int l = 0; l < 2; ++l) {
        SEAM_X(); { Params q; load_params(q, shm); run_sub<0>(q, shm, l); }
        SEAM_X(); { Params q; load_params(q, shm); run_sub<1>(q, shm, l); }
        SEAM_X(); { Params q; load_params(q, shm); run_sub<2>(q, shm, l); }
        SEAM_X(); { Params q; load_params(q, shm); run_sub<3>(q, shm, l); }
        SEAM_X(); { Params q; load_params(q, shm); run_sub<4>(q, shm, l); }
        SEAM_X(); { Params q; load_params(q, shm); run_sub<5>(q, shm, l); }
    }
}

extern "C" void kernel_launch(void* const* d_in, const int* in_sizes, int n_in, void* d_out, int out_size, void* d_ws, size_t ws_size, hipStream_t stream) {
    static int grid = 0;
    if (grid == 0) {
        if (n_in != 18 || ws_size < WS_TOTAL) { fprintf(stderr, "kernel_launch: unexpected n_in %d / ws_size %zu (need %zu)\n", n_in, ws_size, (size_t)WS_TOTAL); grid = -1; return; }
        int dev = 0, cus = 0, per_cu = 0;
        hipGetDevice(&dev); hipDeviceGetAttribute(&cus, hipDeviceAttributeMultiprocessorCount, dev);
        if (hipFuncSetAttribute((const void*)fwd_megakernel, hipFuncAttributeMaxDynamicSharedMemorySize, LDS_BYTES) != hipSuccess) { fprintf(stderr, "kernel_launch: hipFuncSetAttribute failed\n"); grid = -1; return; }
        if (hipOccupancyMaxActiveBlocksPerMultiprocessor(&per_cu, (const void*)fwd_megakernel, 512, LDS_BYTES) != hipSuccess || per_cu < 1) { fprintf(stderr, "kernel_launch: occupancy query says %d blocks/CU\n", per_cu); per_cu = 1; }
        (void)hipGetLastError();
        grid = cus * 1;
        if (grid > 256) grid = 256;
    }
    if (grid < 0) return;
    if (hipMemsetAsync((unsigned char*)d_ws + WS_BAR, 0, (size_t)XCD_BAR_WORDS * 4, stream) != hipSuccess) { fprintf(stderr, "kernel_launch: hipMemsetAsync of the barrier words failed\n"); return; }
    Params p{};
    const float** pp = (const float**)&p;
    for (int i = 0; i < 18; ++i) pp[i] = (const float*)d_in[i];
    p.out = (float*)d_out; p.ws = (unsigned char*)d_ws; p.ph_lo = 0; p.ph_hi = 14;
    void* args[] = {&p};
    hipError_t e = hipLaunchCooperativeKernel((const void*)fwd_megakernel, dim3(grid), dim3(512), args, LDS_BYTES, stream);
    if (e != hipSuccess) fprintf(stderr, "cooperative launch failed: %s (grid %d)\n", hipGetErrorString(e), grid);
}
```
